# Optimizing an MI355X kernel written in HIP

```python
import math
import jax
import jax.numpy as jnp
from jax import lax
import numpy as np

D_MODEL = 1024
BATCH = 4
SEQ = 8192
DEPTH = 2

MIX_WIDTH = D_MODEL
BRANCH_W = MIX_WIDTH // 4
S5_GROUP = 16
S5_GROUPS = BRANCH_W // S5_GROUP
S5_STATE = 64
GMLP_HEADS = 4
GMLP_HEAD_DIM = BRANCH_W // GMLP_HEADS
GMLP_CHUNK = 128
GDN_HEAD_DIM = 64
GDN_HEADS = BRANCH_W // GDN_HEAD_DIM
GDN_CONV = 4
GDN_CHUNK = 64
SC_CONV = 3
IN_SIZES = (BRANCH_W,
            2 * BRANCH_W,
            3 * BRANCH_W,
            BRANCH_W,
            GDN_HEADS,
            GDN_HEADS,
            3 * BRANCH_W)
IN_COLS = sum(IN_SIZES)
D_FF = 2816
N_EXPERTS = 8
TOP_K = 2
D_FF_EXPERT = 3584
MOE_BLOCK = 512
N_DENSE = (DEPTH + 1) // 2
N_MOE = DEPTH // 2
EPS = 1e-6

kernel_name = 'hybrid_parallel_s5_gmlp_gdn_shortconv_moe'


def rmsnorm(x, g):
    xf = x.astype(jnp.float32)
    y = xf * lax.rsqrt(jnp.mean(xf * xf, axis=-1, keepdims=True) + EPS)
    return (y * g.astype(jnp.float32)).astype(x.dtype)


def layernorm(x, g, b):
    xf = x.astype(jnp.float32)
    xc = xf - jnp.mean(xf, axis=-1, keepdims=True)
    y = xc * lax.rsqrt(jnp.mean(xc * xc, axis=-1, keepdims=True) + EPS)
    return (y * g.astype(jnp.float32) + b.astype(jnp.float32)).astype(x.dtype)


def l2norm(x):
    return x * lax.rsqrt(jnp.sum(x * x, axis=-1, keepdims=True) + EPS)


def split_cols(p, sizes):
    out, start = [], 0
    for s in sizes:
        out.append(p[..., start:start + s])
        start += s
    return out


def causal_dwconv(x, w):
    k, c = w.shape
    return lax.conv_general_dilated(x, w[:, None, :].astype(x.dtype), window_strides=(1,),
                                    padding=[(k - 1, 0)], dimension_numbers=('NWC', 'WIO', 'NWC'),
                                    feature_group_count=c)


def s5_mixer(u, lam_re, lam_im, log_step, b_re, b_im, c_re, c_im, d_skip, w_glu, b_glu):
    f32 = jnp.float32
    bsz, seqlen, _ = u.shape
    uf = u.astype(f32)
    ug = uf.reshape(bsz, seqlen, S5_GROUPS, S5_GROUP)
    lr, li = lam_re.astype(f32), lam_im.astype(f32)
    dt = jnp.exp(log_step.astype(f32))[:, None]
    mag = jnp.exp(lr * dt)
    ar, ai = mag * jnp.cos(li * dt), mag * jnp.sin(li * dt)
    den = lr * lr + li * li
    fr = ((ar - 1.0) * lr + ai * li) / den
    fi = (ai * lr - (ar - 1.0) * li) / den
    br, bi = b_re.astype(f32), b_im.astype(f32)
    bbr = fr[..., None] * br - fi[..., None] * bi
    bbi = fr[..., None] * bi + fi[..., None] * br
    bu_r = jnp.einsum('blgp,gnp->blgn', ug, bbr)
    bu_i = jnp.einsum('blgp,gnp->blgn', ug, bbi)
    a_r = jnp.broadcast_to(ar, bu_r.shape)
    a_i = jnp.broadcast_to(ai, bu_i.shape)

    def combine(e1, e2):
        a1r, a1i, b1r, b1i = e1
        a2r, a2i, b2r, b2i = e2
        return (a2r * a1r - a2i * a1i, a2r * a1i + a2i * a1r,
                a2r * b1r - a2i * b1i + b2r, a2r * b1i + a2i * b1r + b2i)

    _, _, s_r, s_i = lax.associative_scan(combine, (a_r, a_i, bu_r, bu_i), axis=1)
    y = (jnp.einsum('blgn,gpn->blgp', s_r, c_re.astype(f32))
         - jnp.einsum('blgn,gpn->blgp', s_i, c_im.astype(f32)))
    y = y.reshape(bsz, seqlen, BRANCH_W) + d_skip.astype(f32) * uf
    y = jax.nn.gelu(y)
    y = y * jax.nn.sigmoid(y @ w_glu.astype(f32) + b_glu.astype(f32))
    return y.astype(u.dtype)


def gmlp_mixer(p, ln_g, ln_b, w_sp, b_sp):
    bsz, seqlen, _ = p.shape
    z = jax.nn.gelu(p)
    u, v = z[..., :BRANCH_W], z[..., BRANCH_W:]
    v = layernorm(v, ln_g, ln_b)
    n = seqlen // GMLP_CHUNK
    vc = v.reshape(bsz, n, GMLP_CHUNK, GMLP_HEADS, GMLP_HEAD_DIM)
    mask = jnp.tril(jnp.ones((GMLP_CHUNK, GMLP_CHUNK), dtype=bool))
    w = jnp.where(mask, w_sp, 0.0).astype(v.dtype)
    s = jnp.einsum('hts,bnshd->bnthd', w, vc) + b_sp.T[:, :, None].astype(v.dtype)
    return u * s.reshape(bsz, seqlen, BRANCH_W)


def gated_delta_rule(q, k, v, g, beta):
    bsz, seqlen, nh, dk = q.shape
    dv = v.shape[-1]
    c = GDN_CHUNK
    n = seqlen // c

    def chunked(t):
        return jnp.moveaxis(t.reshape(bsz, n, c, nh, -1), 3, 1)

    q = chunked(q) * (dk ** -0.5)
    k = chunked(k)
    v = chunked(v)
    g = chunked(g[..., None])[..., 0]
    beta = chunked(beta[..., None])[..., 0]
    G = jnp.cumsum(g, axis=-1)
    causal = jnp.tril(jnp.ones((c, c), dtype=bool))
    strict = jnp.tril(jnp.ones((c, c), dtype=bool), k=-1)
    decay = jnp.exp(jnp.where(causal, G[..., :, None] - G[..., None, :], -jnp.inf))
    a_mat = jnp.where(strict, beta[..., None] * jnp.einsum('bhnid,bhnjd->bhnij', k, k) * decay, 0.0)
    eye = jnp.eye(c, dtype=q.dtype)
    rhs = jnp.concatenate([v * beta[..., None], k * (beta * jnp.exp(G))[..., None]], axis=-1)
    sol = lax.linalg.triangular_solve(eye + a_mat, rhs, left_side=True, lower=True, unit_diagonal=True)
    w_v, w_k = sol[..., :dv], sol[..., dv:]
    qk = jnp.einsum('bhnid,bhnjd->bhnij', q, k) * decay
    q_dec = q * jnp.exp(G)[..., None]
    k_dec = k * jnp.exp(G[..., -1:] - G)[..., None]
    g_tot = jnp.exp(G[..., -1])

    def step(state, xs):
        wv_i, wk_i, qk_i, qd_i, kd_i, gt_i = xs
        v_new = wv_i - jnp.einsum('bhck,bhkv->bhcv', wk_i, state)
        o_i = jnp.einsum('bhck,bhkv->bhcv', qd_i, state) + jnp.einsum('bhcs,bhsv->bhcv', qk_i, v_new)
        state = state * gt_i[..., None, None] + jnp.einsum('bhck,bhcv->bhkv', kd_i, v_new)
        return state, o_i

    xs = tuple(jnp.moveaxis(t, 2, 0) for t in (w_v, w_k, qk, q_dec, k_dec, g_tot))
    s0 = jnp.zeros((bsz, nh, dk, dv), q.dtype)
    _, o = lax.scan(step, s0, xs)
    return jnp.transpose(o, (1, 0, 3, 2, 4)).reshape(bsz, seqlen, nh, dv)


def gdn_mixer(p_qkv, p_z, p_a, p_b, conv_w, a_log, dt_bias, norm_g):
    f32 = jnp.float32
    bsz, seqlen, _ = p_qkv.shape
    qkv = jax.nn.silu(causal_dwconv(p_qkv, conv_w)).astype(f32)
    shp = (bsz, seqlen, GDN_HEADS, GDN_HEAD_DIM)
    q = l2norm(qkv[..., :BRANCH_W].reshape(shp))
    k = l2norm(qkv[..., BRANCH_W:2 * BRANCH_W].reshape(shp))
    v = qkv[..., 2 * BRANCH_W:].reshape(shp)
    beta = jax.nn.sigmoid(p_b.astype(f32))
    g = -jnp.exp(a_log.astype(f32)) * jax.nn.softplus(p_a.astype(f32) + dt_bias.astype(f32))
    o = gated_delta_rule(q, k, v, g, beta)
    o = rmsnorm(o, norm_g) * jax.nn.silu(p_z.astype(f32).reshape(shp))
    return o.reshape(bsz, seqlen, BRANCH_W).astype(p_qkv.dtype)


def shortconv_mixer(p, conv_w):
    b_gate, c_gate, xin = p[..., :BRANCH_W], p[..., BRANCH_W:2 * BRANCH_W], p[..., 2 * BRANCH_W:]
    return b_gate * causal_dwconv(c_gate * xin, conv_w)


def hybrid_mixer(h, w_in, s5_lam_re, s5_lam_im, s5_log_step, s5_b_re, s5_b_im, s5_c_re, s5_c_im,
                 s5_d, s5_w_glu, s5_b_glu, s5_out_norm, sgu_ln_g, sgu_ln_b, sgu_w, sgu_b,
                 gmlp_out_norm, gdn_conv, gdn_a_log, gdn_dt_bias, gdn_norm, sc_conv, sc_out_norm, w_out):
    p = h @ w_in
    p_s5, p_gm, p_qkv, p_z, p_a, p_b, p_sc = split_cols(p, IN_SIZES)
    y_s5 = rmsnorm(s5_mixer(p_s5, s5_lam_re, s5_lam_im, s5_log_step, s5_b_re, s5_b_im,
                            s5_c_re, s5_c_im, s5_d, s5_w_glu, s5_b_glu), s5_out_norm)
    y_gm = rmsnorm(gmlp_mixer(p_gm, sgu_ln_g, sgu_ln_b, sgu_w, sgu_b), gmlp_out_norm)
    y_gdn = gdn_mixer(p_qkv, p_z, p_a, p_b, gdn_conv, gdn_a_log, gdn_dt_bias, gdn_norm)
    y_sc = rmsnorm(shortconv_mixer(p_sc, sc_conv), sc_out_norm)
    return jnp.concatenate([y_s5, y_gm, y_gdn, y_sc], axis=-1) @ w_out


def swiglu(x, w_gate, w_up, w_down):
    return (jax.nn.silu(x @ w_gate) * (x @ w_up)) @ w_down


def moe_swiglu(x2, w_router, w_gate, w_up, w_down):
    t = x2.shape[0]
    n_assign = t * TOP_K
    logits = (x2 @ w_router).astype(jnp.float32)
    top_logit, top_idx = lax.top_k(logits, TOP_K)
    gates = jax.nn.softmax(top_logit, axis=-1)
    flat_e = top_idx.reshape(-1)
    order = jnp.argsort(flat_e)
    sorted_e = flat_e[order]
    tok = order // TOP_K
    counts = jnp.bincount(flat_e, length=N_EXPERTS)
    starts = jnp.cumsum(counts) - counts
    padded = (counts + MOE_BLOCK - 1) // MOE_BLOCK * MOE_BLOCK
    pad_ends = jnp.cumsum(padded)
    pad_starts = pad_ends - padded
    dest = pad_starts[sorted_e] + (jnp.arange(n_assign) - starts[sorted_e])
    n_blocks = -(-n_assign // MOE_BLOCK) + N_EXPERTS
    buf = jnp.zeros((n_blocks * MOE_BLOCK, x2.shape[1]), x2.dtype).at[dest].set(x2[tok])
    block_e = jnp.minimum(jnp.searchsorted(pad_ends, jnp.arange(n_blocks) * MOE_BLOCK, side='right'),
                          N_EXPERTS - 1)

    def run(args):
        xb, e = args
        return swiglu(xb, w_gate[e], w_up[e], w_down[e])

    y_buf = lax.map(run, (buf.reshape(n_blocks, MOE_BLOCK, -1), block_e)).reshape(n_blocks * MOE_BLOCK, -1)
    y = y_buf[dest] * gates.reshape(-1)[order][:, None].astype(x2.dtype)
    return jnp.zeros_like(x2).at[tok].add(y)


def setup_inputs(seed: int = 0) -> dict:
    key = jax.random.key(seed)
    keys = iter(jax.random.split(key, 40))
    f32 = jnp.float32

    def nrm(shape, scale):
        return scale * jax.random.normal(next(keys), shape, f32)

    def gain(shape):
        return 1.0 + 0.02 * jax.random.normal(next(keys), shape, f32)

    L = DEPTH
    n_idx = jnp.arange(S5_STATE, dtype=f32)
    dt = jnp.exp(jax.random.uniform(next(keys), (L, GDN_HEADS), f32, math.log(1e-3), math.log(1e-1)))
    return {
        'x': nrm((BATCH, SEQ, D_MODEL), 1.0),
        'mix_norm': gain((L, D_MODEL)),
        'w_in': nrm((L, D_MODEL, IN_COLS), D_MODEL ** -0.5),
        's5_lam_re': -0.5 + nrm((L, S5_GROUPS, S5_STATE), 0.01),
        's5_lam_im': math.pi * n_idx + nrm((L, S5_GROUPS, S5_STATE), 0.01),
        's5_log_step': jax.random.uniform(next(keys), (L, S5_GROUPS), f32, math.log(1e-3), math.log(1e-1)),
        's5_b_re': nrm((L, S5_GROUPS, S5_STATE, S5_GROUP), (2 * S5_GROUP) ** -0.5),
        's5_b_im': nrm((L, S5_GROUPS, S5_STATE, S5_GROUP), (2 * S5_GROUP) ** -0.5),
        's5_c_re': nrm((L, S5_GROUPS, S5_GROUP, S5_STATE), 0.5),
        's5_c_im': nrm((L, S5_GROUPS, S5_GROUP, S5_STATE), 0.5),
        's5_d': nrm((L, BRANCH_W), 1.0),
        's5_w_glu': nrm((L, BRANCH_W, BRANCH_W), BRANCH_W ** -0.5),
        's5_b_glu': nrm((L, BRANCH_W), 0.02),
        's5_out_norm': gain((L, BRANCH_W)),
        'sgu_ln_g': gain((L, BRANCH_W)),
        'sgu_ln_b': nrm((L, BRANCH_W), 0.02),
        'sgu_w': nrm((L, GMLP_HEADS, GMLP_CHUNK, GMLP_CHUNK), 0.5 * GMLP_CHUNK ** -0.5),
        'sgu_b': 1.0 + nrm((L, GMLP_HEADS, GMLP_CHUNK), 0.1),
        'gmlp_out_norm': gain((L, BRANCH_W)),
        'gdn_conv': nrm((L, GDN_CONV, 3 * BRANCH_W), GDN_CONV ** -0.5),
        'gdn_a_log': jnp.log(jax.random.uniform(next(keys), (L, GDN_HEADS), f32, 1.0, 16.0)),
        'gdn_dt_bias': dt + jnp.log(-jnp.expm1(-dt)),
        'gdn_norm': gain((L, GDN_HEAD_DIM)),
        'sc_conv': nrm((L, SC_CONV, BRANCH_W), SC_CONV ** -0.5),
        'sc_out_norm': gain((L, BRANCH_W)),
        'w_out': nrm((L, MIX_WIDTH, D_MODEL), MIX_WIDTH ** -0.5),
        'ffn_norm': gain((L, D_MODEL)),
        'ffn_w_gate': nrm((N_DENSE, D_MODEL, D_FF), D_MODEL ** -0.5),
        'ffn_w_up': nrm((N_DENSE, D_MODEL, D_FF), D_MODEL ** -0.5),
        'ffn_w_down': nrm((N_DENSE, D_FF, D_MODEL), D_FF ** -0.5),
        'moe_router': nrm((N_MOE, D_MODEL, N_EXPERTS), D_MODEL ** -0.5),
        'moe_w_gate': nrm((N_MOE, N_EXPERTS, D_MODEL, D_FF_EXPERT), D_MODEL ** -0.5),
        'moe_w_up': nrm((N_MOE, N_EXPERTS, D_MODEL, D_FF_EXPERT), D_MODEL ** -0.5),
        'moe_w_down': nrm((N_MOE, N_EXPERTS, D_FF_EXPERT, D_MODEL), D_FF_EXPERT ** -0.5),
        'final_norm': gain((D_MODEL,)),
    }


def reference(x, mix_norm, w_in, s5_lam_re, s5_lam_im, s5_log_step, s5_b_re, s5_b_im, s5_c_re, s5_c_im,
              s5_d, s5_w_glu, s5_b_glu, s5_out_norm, sgu_ln_g, sgu_ln_b, sgu_w, sgu_b, gmlp_out_norm,
              gdn_conv, gdn_a_log, gdn_dt_bias, gdn_norm, sc_conv, sc_out_norm, w_out, ffn_norm,
              ffn_w_gate, ffn_w_up, ffn_w_down, moe_router, moe_w_gate, moe_w_up, moe_w_down, final_norm):
    bsz, seqlen, d = x.shape
    for l in range(DEPTH):
        h = rmsnorm(x, mix_norm[l])
        x = x + hybrid_mixer(h, w_in[l], s5_lam_re[l], s5_lam_im[l], s5_log_step[l], s5_b_re[l], s5_b_im[l],
                             s5_c_re[l], s5_c_im[l], s5_d[l], s5_w_glu[l], s5_b_glu[l], s5_out_norm[l],
                             sgu_ln_g[l], sgu_ln_b[l], sgu_w[l], sgu_b[l], gmlp_out_norm[l],
                             gdn_conv[l], gdn_a_log[l], gdn_dt_bias[l], gdn_norm[l],
                             sc_conv[l], sc_out_norm[l], w_out[l])
        h = rmsnorm(x, ffn_norm[l])
        i = l // 2
        if l % 2 == 0:
            x = x + swiglu(h, ffn_w_gate[i], ffn_w_up[i], ffn_w_down[i])
        else:
            x = x + moe_swiglu(h.reshape(bsz * seqlen, d), moe_router[i], moe_w_gate[i],
                               moe_w_up[i], moe_w_down[i]).reshape(bsz, seqlen, d)
    return rmsnorm(x, final_norm)
```

```cpp
#include <hip/hip_runtime.h>
#include <cstdio>
#include <cstdint>

#ifndef PH_MASK
#define PH_MASK 0xFFFFFFFFu
#endif
#define PH(k) (((PH_MASK) >> (k)) & 1u)
#ifndef REP_MASK
#define REP_MASK 0u
#endif
#define REPS(k) ((((REP_MASK) >> (k)) & 1u) ? 2 : 1)
#ifndef MK_ONE_LAUNCH
#define MK_ONE_LAUNCH 1
#endif

#define DI __device__ __forceinline__
#define LAS __attribute__((address_space(3)))
#define GAS __attribute__((address_space(1)))
typedef unsigned short bf16;
typedef short bf16x8 __attribute__((ext_vector_type(8)));
typedef float f32x4 __attribute__((ext_vector_type(4)));
typedef float f32x2 __attribute__((ext_vector_type(2)));
typedef unsigned u32x4 __attribute__((ext_vector_type(4)));
typedef unsigned u32x2 __attribute__((ext_vector_type(2)));

constexpr int NB = 4, SEQ = 8192, D = 1024, T = NB * SEQ;
constexpr int NP = 2560;
constexpr int PC_S5 = 0, PC_GU = 256, PC_GV = 512, PC_Q = 768, PC_Z = 1536, PC_SCB = 1792, PC_SCC = 2048, PC_SCX = 2304;
constexpr int IN_COLS = 2568, DFF = 2816, NEXP = 8, DFE = 3584;
constexpr int S5CS = 128, S5NC = SEQ / S5CS;
constexpr float EPS = 1e-6f;
constexpr int NWAVES = 8, NTHR = 512;
constexpr int MAXPANEL = 264, PASSP = 64;

constexpr float F8_SA = 16.f, F8_SW = 256.f, F8_SH = 8.f, F8_SWD = 512.f;
constexpr size_t MiB = 1u << 20;
constexpr size_t WS_CTL = 0, CTL_ZERO_BYTES = 1 * MiB;
constexpr size_t WS_SMALL = 1 * MiB;
constexpr size_t WS_WIN = 4 * MiB, WS_WOUT = 14 * MiB, WS_WGU = 18 * MiB, WS_WDN = 29 * MiB, WS_WGLU = 35 * MiB, WS_MGU = 36 * MiB, WS_MDN = 148 * MiB;
constexpr size_t WS_H = 204 * MiB;
constexpr size_t WS_A = 268 * MiB;
constexpr size_t WS_YB0 = WS_A + 112 * MiB;
constexpr size_t WS_B = 444 * MiB;
constexpr size_t WS_MISC = 512 * MiB;
constexpr size_t WS_END = 520 * MiB;
constexpr size_t WS_SGW = WS_SMALL + 1 * MiB;
constexpr size_t WS_HS = WS_WIN;
constexpr size_t WS_GOP = WS_MGU;
constexpr size_t WS_GO = WS_A + 160 * MiB;
constexpr int GOP_ISTRIDE = 50176;
constexpr int SM_AR = 0, SM_AI = 2048, SM_PR = 4096, SM_PI = 6144;
constexpr int SM_BBR = 8192, SM_BBI = SM_BBR + 32768;
constexpr int SM_WAB = SM_BBI + 32768;
constexpr int SM_WR = SM_WAB + 16384;
constexpr int SM_END = SM_WR + 8192;
constexpr size_t MS_AB = 0;
constexpr size_t MS_GB = 5 * MiB;
constexpr size_t MS_E = 1 * MiB;
constexpr size_t MS_TE = 3 * MiB;
constexpr size_t MS_TG = MS_TE + (size_t)T * 8;
constexpr size_t MS_TS = MS_TG + (size_t)T * 8;
constexpr size_t MS_ST = MS_TS + (size_t)T * 8;
constexpr size_t MS_CNT = MS_ST + (size_t)MAXPANEL * 256 * 4;
constexpr size_t MS_SEG = MS_CNT + 256 * 8 * 4;
constexpr int CW_BAR = 4096;

constexpr int RING_BYTES = 131072, LDSCTL_OFF = 155648, MISC_OFF = LDSCTL_OFF + 320, RTAB_OFF = RING_BYTES, LDS_BYTES = 159744;

DI float bf2f(unsigned b) { return __uint_as_float(b << 16); }
typedef __bf16 bf16x2_t __attribute__((ext_vector_type(2)));
DI unsigned cvtpk(float lo, float hi) { f32x2 v = {lo, hi}; bf16x2_t b = __builtin_convertvector(v, bf16x2_t); return __builtin_bit_cast(unsigned, b); }
DI unsigned f2bf(float f) { return cvtpk(f, f); }
DI unsigned pk2(float lo, float hi) { return cvtpk(lo, hi); }
template <int CTRL> DI float dpp_mov(float v) { return __builtin_bit_cast(float, __builtin_amdgcn_update_dpp(0, __builtin_bit_cast(int, v), CTRL, 0xf, 0xf, true)); }
DI float row_sum16(float v) {
    v += dpp_mov<0xB1>(v); v += dpp_mov<0x4E>(v); v += dpp_mov<0x141>(v); v += dpp_mov<0x140>(v); return v;
}
DI float wave_sum(float v) {
    v = row_sum16(v);
    const int i = __builtin_bit_cast(int, v);
    return (__builtin_bit_cast(float, __builtin_amdgcn_readlane(i, 0)) + __builtin_bit_cast(float, __builtin_amdgcn_readlane(i, 16))) + (__builtin_bit_cast(float, __builtin_amdgcn_readlane(i, 32)) + __builtin_bit_cast(float, __builtin_amdgcn_readlane(i, 48)));
}
DI float rcpf_(float x) { return __builtin_amdgcn_rcpf(x); }
DI float rsqf_(float x) { return __builtin_amdgcn_rsqf(x); }
DI float sigmoidf_(float x) { return rcpf_(1.0f + __expf(-x)); }
DI float siluf_(float x) { return x * rcpf_(1.0f + __expf(-x)); }
DI float gelu_tanh(float x) { const float z = 0.7978845608028654f * (x + 0.044715f * x * x * x); const float e = __expf(2.0f * z); return 0.5f * x * (2.0f - 2.0f * rcpf_(e + 1.0f)); }
DI float softplusf_(float x) { return fmaxf(x, 0.f) + log1pf(__expf(-fabsf(x))); }
#define LDS_WAIT() asm volatile("s_waitcnt lgkmcnt(0)" ::: "memory")
#define VM_WAIT() asm volatile("s_waitcnt vmcnt(0)" ::: "memory")

#define XB_TMO      128
#define XB_XCNT(j)  (256  + 64 * (j))
#define XB_XSUB(j)  (1280 + 64 * (j))
#define XB_XGEN(j)  (2304 + 64 * (j))
#define XB_TOP      3328
#define XB_TOPGEN   3392
#define XCD_BAR_WORDS 3456
#define XB_SPIN_CAP (1u << 24)
DI unsigned xb_ld(unsigned* p)              { return __hip_atomic_load(p, __ATOMIC_RELAXED, __HIP_MEMORY_SCOPE_AGENT); }
DI unsigned xb_add(unsigned* p, unsigned v) { return __hip_atomic_fetch_add(p, v, __ATOMIC_RELAXED, __HIP_MEMORY_SCOPE_AGENT); }
DI unsigned xb_xcc_id() { return (unsigned)__builtin_amdgcn_s_getreg((3 << 11) | 20) & 0xFu; }
#define XB_SPIN(cond, bar) do { unsigned _sp = 0; while (cond) { __builtin_amdgcn_s_sleep(1); \
    if ((++_sp & 255u) == 0u) { if (xb_ld(&(bar)[XB_TMO])) break; if (_sp > XB_SPIN_CAP) { atomicAdd(&(bar)[XB_TMO], 1u); break; } } } } while (0)
struct XcdBarrier { unsigned* bar; unsigned x; volatile LAS unsigned* st; };
DI XcdBarrier xcd_barrier_post(unsigned* bar, volatile LAS unsigned* st) {
    XcdBarrier b; b.bar = bar; b.x = xb_xcc_id(); b.st = st;
    if (threadIdx.x == 0) (void)xb_add(&bar[XB_XCNT(b.x)], 1u);
    return b;
}
DI void xcd_barrier_complete(unsigned* bar, unsigned x, unsigned& nloc, unsigned& nx) {
    const unsigned G = gridDim.x * gridDim.y * gridDim.z;
    unsigned sum, cnt, mine, sp = 0u;
    for (;;) {
        sum = 0u; cnt = 0u; mine = 0u;
#pragma unroll
        for (unsigned j = 0; j < 16; ++j) { const unsigned c = xb_ld(&bar[XB_XCNT(j)]); sum += c; cnt += (c > 0u) ? 1u : 0u; mine = (j == x) ? c : mine; }
        if (sum == G) break;
        __builtin_amdgcn_s_sleep(1);
        if ((++sp & 255u) == 0u) { if (xb_ld(&bar[XB_TMO])) break; if (sp > XB_SPIN_CAP) { atomicAdd(&bar[XB_TMO], 1u); break; } }
    }
    nloc = mine > 0u ? mine : 1u; nx = cnt > 0u ? cnt : 1u;
}
DI void xcd_barrier(const XcdBarrier& b) {
    asm volatile("s_waitcnt vmcnt(0)" ::: "memory");
    __syncthreads();
    if (threadIdx.x == 0) {
        unsigned* bar = b.bar;
        __builtin_amdgcn_s_waitcnt(0);
        unsigned nloc = b.st[0], nx = b.st[1];
        if (nloc == 0u) { xcd_barrier_complete(bar, b.x, nloc, nx); b.st[0] = nloc; b.st[1] = nx; }
        const unsigned old = xb_add(&bar[XB_XSUB(b.x)], 1u);
        const unsigned gen = old / nloc;
        if (old + 1u == (gen + 1u) * nloc) {
            __builtin_amdgcn_fence(__ATOMIC_RELEASE, "agent");
            asm volatile("s_waitcnt vmcnt(0)" ::: "memory");
            const unsigned og = xb_add(&bar[XB_TOP], 1u);
            const unsigned tg = og / nx;
            if (og + 1u == (tg + 1u) * nx) xb_add(&bar[XB_TOPGEN], 1u);
            else XB_SPIN(xb_ld(&bar[XB_TOPGEN]) == tg, bar);
            __builtin_amdgcn_fence(__ATOMIC_ACQUIRE, "agent");
            xb_add(&bar[XB_XGEN(b.x)], 1u);
            asm volatile("s_waitcnt vmcnt(0)" ::: "memory");
        } else {
            XB_SPIN(xb_ld(&bar[XB_XGEN(b.x)]) == gen, bar);
            __builtin_amdgcn_fence(__ATOMIC_ACQUIRE, "agent");
            asm volatile("s_waitcnt vmcnt(0)" ::: "memory");
        }
    }
    __syncthreads();
}

namespace pg8 {
constexpr int BM = 256, BK = 64, HALF = 128, HTB = HALF * BK * 2, STAGE_BYTES = 8 * HTB, NXCD = 8, WGM = 4;
DI int lds_byte(int r, int c) { const int st = (r >> 4) * 2 + (c >> 5), rr = r & 15, cc = c & 31, ob = rr * 64 + cc * 2; return st * 1024 + (ob ^ (((ob >> 9) & 1) << 5)); }
DI void stage_rc(int b, int& R, int& C) { const int st = b / 1024, sb = b % 1024, swz = sb ^ (((sb >> 9) & 1) << 5); R = (st >> 1) * 16 + swz / 64; C = (st & 1) * 32 + (swz % 64) / 2; }
DI int perm32(int rho) { const int n = rho >> 4, i = rho & 15; return 8 * (i >> 2) + 4 * n + (i & 3); }
DI unsigned cvt_pk_bf16(float lo, float hi) { unsigned r; asm volatile("v_cvt_pk_bf16_f32 %0, %1, %2" : "=v"(r) : "v"(lo), "v"(hi)); return r; }

typedef int i32x8 __attribute__((ext_vector_type(8)));
typedef int i32x4v __attribute__((ext_vector_type(4)));
DI i32x8 pack8(bf16x8 lo, bf16x8 hi) { return __builtin_shufflevector(__builtin_bit_cast(i32x4v, lo), __builtin_bit_cast(i32x4v, hi), 0, 1, 2, 3, 4, 5, 6, 7); }
DI float clamp8(float x) { return __builtin_fminf(__builtin_fmaxf(x, -448.f), 448.f); }
DI unsigned pk_fp8x4(float a, float b, float c, float d) {
    int w = __builtin_amdgcn_cvt_pk_fp8_f32(clamp8(a), clamp8(b), 0, false); w = __builtin_amdgcn_cvt_pk_fp8_f32(clamp8(c), clamp8(d), w, true); return (unsigned)w; }
struct Unit { int pm, pn; int arow0; const char* B; };

DI bool tile_of(int i, int G, int c, int nM, int nN, int& pm, int& pn) {
    const int nwg = nM * nN; const long L = (long)i * G + c; if (L >= nwg) return false;
    int wgid = (int)L; { const int q = nwg / NXCD, r = nwg % NXCD, xcd = wgid % NXCD, off = wgid / NXCD; wgid = (xcd < r ? xcd * (q + 1) : r * (q + 1) + (xcd - r) * q) + off; }
    const int nig = WGM * nN, gid = wgid / nig, fm = gid * WGM, gsz = (nM - fm) < WGM ? (nM - fm) : WGM;
    pm = fm + ((wgid % nig) % gsz); pn = (wgid % nig) / gsz; return true;
}

template <class Epi, class Sched, int K, bool GATHER, bool ALIGN_EPI, bool SP2, bool FP8 = false>
DI void gemm_phase(LAS unsigned char* lds, const int tid, const bf16* Abase, const int* rowmap, LAS int* rtab, const Sched& S, const Epi& E) {
    const int wid = __builtin_amdgcn_readfirstlane(tid >> 6), lane = tid & 63, wr = wid >> 2, wc = wid & 3, fr = lane & 15, fq = lane >> 4;
    constexpr int nt = K / BK;
    unsigned voffB[2];
#pragma unroll
    for (int i = 0; i < 2; ++i) { int R, C; stage_rc(tid * 16 + i * 8192, R, C); const int Rb = Epi::PERM ? ((R & ~31) + perm32(R & 31)) : R; voffB[i] = (unsigned)(Rb * K + C) * 2u; }
    constexpr size_t kstep = (size_t)(BK * 2);
    constexpr size_t hstep = (size_t)HALF * K * 2;
    const unsigned ldsw = (unsigned)wid * 1024u;
    const int aoff = lds_byte(wr * 64 + fr, fq * 8), boff = lds_byte(wc * 32 + fr, fq * 8);
#define PG8_SA(b, h) (((b) * 2 + (h)) * HTB)
#define PG8_SB(b, h) ((4 + (b) * 2 + (h)) * HTB)
#define PG8_STAGE(bufoff, gbase, voff) do { _Pragma("unroll") for (int _i = 0; _i < 2; ++_i) \
        __builtin_amdgcn_global_load_lds((const unsigned*)((const char*)(gbase) + (voff)[_i]), (LAS unsigned*)(lds + (bufoff) + ldsw + _i * 8192), 16, 0, 0); } while (0)
#define PG8_LDA(dst, b, h) do { _Pragma("unroll") for (int m = 0; m < 4; ++m) { if constexpr (FP8) { dst##8[m] = __builtin_shufflevector(*(const LAS i32x4v*)(lds + PG8_SA(b, h) + aoff + m * 2048), *(const LAS i32x4v*)(lds + PG8_SA(b, h) + aoff + m * 2048 + 1024), 0, 1, 2, 3, 4, 5, 6, 7); } \
        else { _Pragma("unroll") for (int k = 0; k < 2; ++k) dst[m][k] = *(const LAS bf16x8*)(lds + PG8_SA(b, h) + aoff + m * 2048 + k * 1024); } } } while (0)
#define PG8_LDB(dst, b, h) do { _Pragma("unroll") for (int n = 0; n < 2; ++n) { if constexpr (FP8) { dst##8[n] = __builtin_shufflevector(*(const LAS i32x4v*)(lds + PG8_SB(b, h) + boff + n * 2048), *(const LAS i32x4v*)(lds + PG8_SB(b, h) + boff + n * 2048 + 1024), 0, 1, 2, 3, 4, 5, 6, 7); } \
        else { _Pragma("unroll") for (int k = 0; k < 2; ++k) dst[n][k] = *(const LAS bf16x8*)(lds + PG8_SB(b, h) + boff + n * 2048 + k * 1024); } } } while (0)
#define PG8_MMA(ai, bj, At, Bt) do { __builtin_amdgcn_s_setprio(1); _Pragma("unroll") for (int m = 0; m < 4; ++m) _Pragma("unroll") for (int n = 0; n < 2; ++n) { \
        if constexpr (FP8) { asm volatile("v_mfma_f32_16x16x128_f8f6f4 %0, %1, %2, %0" : "+v"(acc[ai][bj][m][n]) : "v"(Bt##8[n]), "v"(At##8[m])); } \
        else { _Pragma("unroll") for (int k = 0; k < 2; ++k) acc[ai][bj][m][n] = __builtin_amdgcn_mfma_f32_16x16x32_bf16(Bt[n][k], At[m][k], acc[ai][bj][m][n], 0, 0, 0); } } \
        __builtin_amdgcn_s_setprio(0); } while (0)
#define PG8_WAIT_V(n) asm volatile("s_waitcnt vmcnt(" #n ")" ::: "memory")
#define PG8_WAIT_L(n) asm volatile("s_waitcnt lgkmcnt(" #n ")" ::: "memory")
#define PG8_BAR __builtin_amdgcn_s_barrier()
#define PG8_SCHED __builtin_amdgcn_sched_barrier(0)
#define PG8_AOFF(dst, arow0_, MODE) do { _Pragma("unroll") for (int _i = 0; _i < 2; ++_i) { int _R, _C; stage_rc(tid * 16 + _i * 8192, _R, _C); _Pragma("unroll") for (int _h = 0; _h < 2; ++_h) { \
        int _r = (arow0_) + _h * HALF + _R; if ((MODE) == 1) _r = rowmap[_r]; if ((MODE) == 2) _r = rtab[(arow0_) + _h * HALF + _R]; dst[_h][_i] = (unsigned)(_r * K + _C) * 2u; } } } while (0)
    Unit cur, nxt; int ui = 0;
    if (!S.next(0, cur)) return;
    f32x4 acc[2][2][4][2];
#pragma unroll
    for (int a = 0; a < 2; ++a)
#pragma unroll
        for (int b = 0; b < 2; ++b)
#pragma unroll
            for (int m = 0; m < 4; ++m)
#pragma unroll
                for (int n = 0; n < 2; ++n) acc[a][b][m][n] = (f32x4){0.f, 0.f, 0.f, 0.f};
    bf16x8 At[4][2], B0[2][2], B1[2][2]; i32x8 At8[4], B08[2], B18[2];
    unsigned fA[2][2], c1[2];
    if constexpr (GATHER) {
        { Unit uu; for (int i = 0; i < 8 && S.next(i, uu); ++i) if (tid < 256) rtab[i * 256 + tid] = rowmap[uu.arow0 + tid]; }
        asm volatile("s_waitcnt vmcnt(0) lgkmcnt(0)" ::: "memory"); __builtin_amdgcn_s_barrier(); asm volatile("" ::: "memory");
        PG8_AOFF(fA, 0, 2);
    } else { PG8_AOFF(fA, cur.arow0, 0); }
    c1[0] = fA[1][0]; c1[1] = fA[1][1];
    const char* gA = (const char*)Abase;
    const char* cB = cur.B;
    if constexpr (SP2) {
        PG8_STAGE(PG8_SB(0, 0), cB, voffB); PG8_STAGE(PG8_SB(0, 1), cB + hstep, voffB); PG8_STAGE(PG8_SA(0, 0), gA, fA[0]); PG8_STAGE(PG8_SA(0, 1), gA, fA[1]);
        if (wr == 1) PG8_BAR;
        PG8_WAIT_V(2); PG8_BAR;
        PG8_STAGE(PG8_SB(1, 0), cB + kstep, voffB); PG8_STAGE(PG8_SA(1, 0), gA + kstep, fA[0]); PG8_STAGE(PG8_SB(1, 1), cB + hstep + kstep, voffB);
        PG8_WAIT_V(6); PG8_BAR;
    } else {
        PG8_STAGE(PG8_SB(0, 0), cB, voffB); PG8_STAGE(PG8_SA(0, 0), gA, fA[0]); PG8_STAGE(PG8_SB(0, 1), cB + hstep, voffB); PG8_STAGE(PG8_SA(0, 1), gA, fA[1]);
        if (wr == 1) PG8_BAR;
        PG8_WAIT_V(4); PG8_BAR;
        PG8_STAGE(PG8_SB(1, 0), cB + kstep, voffB); PG8_STAGE(PG8_SA(1, 0), gA + kstep, fA[0]); PG8_STAGE(PG8_SB(1, 1), cB + hstep + kstep, voffB);
        PG8_WAIT_V(6); PG8_BAR;
    }
    for (;;) {
        const bool has_next = S.next(ui + 1, nxt);
        const char* nB = has_next ? nxt.B : cB;
#pragma unroll 1
        for (int t = 0; t < nt; t += 2) {
            const bool last = (t == nt - 2);
            const char* a1 = gA + (size_t)(t + 1) * kstep;
            const char* a2 = last ? gA : gA + (size_t)(t + 2) * kstep; const char* b2 = last ? nB : cB + (size_t)(t + 2) * kstep;
            const char* a3 = a2 + kstep; const char* b3 = b2 + kstep;
            if (last && has_next) { if constexpr (GATHER) { PG8_AOFF(fA, (ui + 1) * 256, 2); } else { PG8_AOFF(fA, nxt.arow0, 0); } }
            if constexpr (SP2) {
            PG8_LDB(B0, 0, 0); PG8_LDB(B1, 0, 1); PG8_SCHED; PG8_LDA(At, 0, 0); PG8_STAGE(PG8_SA(1, 1), a1, c1);
            PG8_WAIT_V(8); PG8_WAIT_L(0); PG8_BAR; PG8_MMA(0, 0, At, B0); PG8_MMA(0, 1, At, B1); PG8_BAR; PG8_SCHED;
            PG8_LDA(At, 0, 1); PG8_STAGE(PG8_SB(0, 0), b2, voffB); PG8_STAGE(PG8_SB(0, 1), b2 + hstep, voffB); PG8_STAGE(PG8_SA(0, 0), a2, fA[0]);
            PG8_WAIT_V(8); PG8_WAIT_L(0); PG8_BAR; PG8_MMA(1, 0, At, B0); PG8_MMA(1, 1, At, B1); PG8_BAR; PG8_SCHED;
            PG8_LDB(B0, 1, 0); PG8_LDB(B1, 1, 1); PG8_SCHED; PG8_LDA(At, 1, 0); PG8_STAGE(PG8_SA(0, 1), a2, fA[1]);
            PG8_WAIT_V(8); PG8_WAIT_L(0); PG8_BAR; PG8_MMA(0, 0, At, B0); PG8_MMA(0, 1, At, B1); PG8_BAR; PG8_SCHED;
            PG8_LDA(At, 1, 1); PG8_STAGE(PG8_SB(1, 0), b3, voffB); PG8_STAGE(PG8_SB(1, 1), b3 + hstep, voffB); PG8_STAGE(PG8_SA(1, 0), a3, fA[0]);
            PG8_WAIT_V(8); PG8_WAIT_L(0); PG8_BAR; PG8_MMA(1, 0, At, B0); PG8_MMA(1, 1, At, B1); PG8_BAR; PG8_SCHED;
            } else {
            PG8_LDB(B0, 0, 0); PG8_SCHED; PG8_LDA(At, 0, 0); PG8_STAGE(PG8_SA(1, 1), a1, c1);
            PG8_WAIT_L(8); PG8_BAR; PG8_WAIT_L(0); PG8_MMA(0, 0, At, B0); PG8_BAR; PG8_SCHED;
            PG8_LDB(B1, 0, 1); PG8_STAGE(PG8_SB(0, 0), b2, voffB);
            PG8_BAR; PG8_WAIT_L(0); PG8_MMA(0, 1, At, B1); PG8_BAR;
            PG8_LDA(At, 0, 1); PG8_STAGE(PG8_SA(0, 0), a2, fA[0]);
            PG8_BAR; PG8_WAIT_L(0); PG8_MMA(1, 0, At, B0); PG8_BAR; PG8_SCHED;
            PG8_STAGE(PG8_SB(0, 1), b2 + hstep, voffB);
            PG8_WAIT_V(6); PG8_BAR; PG8_MMA(1, 1, At, B1); PG8_BAR;
            PG8_LDB(B0, 1, 0); PG8_SCHED; PG8_LDA(At, 1, 0); PG8_STAGE(PG8_SA(0, 1), a2, fA[1]);
            PG8_WAIT_L(8); PG8_BAR; PG8_WAIT_L(0); PG8_MMA(0, 0, At, B0); PG8_BAR; PG8_SCHED;
            PG8_LDB(B1, 1, 1); PG8_STAGE(PG8_SB(1, 0), b3, voffB);
            PG8_BAR; PG8_WAIT_L(0); PG8_MMA(0, 1, At, B1); PG8_BAR;
            PG8_LDA(At, 1, 1); PG8_STAGE(PG8_SA(1, 0), a3, fA[0]);
            PG8_BAR; PG8_WAIT_L(0); PG8_MMA(1, 0, At, B0); PG8_BAR; PG8_SCHED;
            PG8_STAGE(PG8_SB(1, 1), b3 + hstep, voffB);
            PG8_WAIT_V(6); PG8_BAR; PG8_MMA(1, 1, At, B1); PG8_BAR;
            }
        }
        if constexpr (ALIGN_EPI) { if (wr == 0) PG8_BAR; }
        if constexpr (FP8) { asm volatile("s_nop 15\n s_nop 15" ::: "memory"); }
        E(acc, cur, wr, wc, fr, fq);
        if (!has_next) break;
#pragma unroll
        for (int a = 0; a < 2; ++a)
#pragma unroll
            for (int b = 0; b < 2; ++b)
#pragma unroll
                for (int m = 0; m < 4; ++m)
#pragma unroll
                    for (int n = 0; n < 2; ++n) acc[a][b][m][n] = (f32x4){0.f, 0.f, 0.f, 0.f};
        cur = nxt; cB = nB; ++ui; c1[0] = fA[1][0]; c1[1] = fA[1][1];
        if constexpr (ALIGN_EPI) { if (wr == 1) PG8_BAR; }
    }
    PG8_WAIT_V(0);
    if constexpr (!ALIGN_EPI) { if (wr == 0) PG8_BAR; }
    PG8_BAR;
#undef PG8_SA
#undef PG8_SB
#undef PG8_STAGE
#undef PG8_LDA
#undef PG8_LDB
#undef PG8_MMA
#undef PG8_WAIT_V
#undef PG8_WAIT_L
#undef PG8_BAR
#undef PG8_SCHED
#undef PG8_AOFF
}

struct DenseOrder {
    int nM, nN, G, c, K; const bf16* Bt;
    DI bool next(int i, Unit& u) const { int pm, pn; if (!tile_of(i, G, c, nM, nN, pm, pn)) return false; u.pm = pm; u.pn = pn; u.arow0 = pm * BM; u.B = (const char*)(Bt + (size_t)pn * BM * K); return true; }
};
struct MoeOrder {
    int nM, nN, G, c, K, p0; const bf16* Bt; size_t estride; const int* seg; bool a_local;
    int nx;
    DI bool next(int i, Unit& u) const {
        int pm, pn;
        if (nx == 0 || i < 4) { if (!tile_of(i, G, c, nM, nN, pm, pn)) return false; }
        else { if (c < nx) return false; if (!tile_of(0, 1, 4 * G + (i - 4) * (G - nx) + (c - nx), nM, nN, pm, pn)) return false; }
        const int panel = p0 + pm, slot0 = panel * BM; int e = 0;
#pragma unroll
        for (int j = 1; j < 8; ++j) e += (slot0 >= seg[j]) ? 1 : 0;
        u.pm = pm; u.pn = pn; u.arow0 = a_local ? pm * BM : slot0; u.B = (const char*)(Bt + (size_t)e * estride + (size_t)pn * BM * K); return true;
    }
};

struct EpiStoreBf16 {
    static constexpr bool PERM = true;
    bf16* O; int ldc; int prow0;
    bf16* O2; int split_row;
    DI void operator()(const f32x4 (&acc)[2][2][4][2], const Unit& u, int wr, int wc, int fr, int fq) const {
        int rowt = (u.pm + prow0) * BM; bf16* base = O; if (O2 && rowt >= split_row) { base = O2; rowt -= split_row; }
        const int row0 = rowt + wr * 64 + fr, col0 = u.pn * BM + wc * 32 + 8 * fq;
#pragma unroll
        for (int ai = 0; ai < 2; ++ai)
#pragma unroll
            for (int m = 0; m < 4; ++m) { bf16* rowp = base + (size_t)(row0 + ai * HALF + m * 16) * ldc + col0;
#pragma unroll
                for (int bj = 0; bj < 2; ++bj) { const f32x4 v0 = acc[ai][bj][m][0], v1 = acc[ai][bj][m][1];
                    u32x4 w; w.x = cvt_pk_bf16(v0[0], v0[1]); w.y = cvt_pk_bf16(v0[2], v0[3]); w.z = cvt_pk_bf16(v1[0], v1[1]); w.w = cvt_pk_bf16(v1[2], v1[3]);
                    *(u32x4*)(rowp + bj * HALF) = w; } }
    }
};
template <bool RES_F32, bool SCALED = false> struct EpiResBf16 {
    static constexpr bool PERM = true;
    const void* res; bf16* hb; int ldc; float scale;
    DI void operator()(const f32x4 (&acc)[2][2][4][2], const Unit& u, int wr, int wc, int fr, int fq) const {
        const int row0 = u.pm * BM + wr * 64 + fr, col0 = u.pn * BM + wc * 32 + 8 * fq;
#pragma unroll
        for (int ai = 0; ai < 2; ++ai)
#pragma unroll
            for (int m = 0; m < 4; ++m) { const size_t off = (size_t)(row0 + ai * HALF + m * 16) * ldc + col0;
#pragma unroll
                for (int bj = 0; bj < 2; ++bj) { f32x4 r0, r1;
                    if constexpr (RES_F32) { const float* rp = (const float*)res + off + bj * HALF; r0 = *(const f32x4*)rp; r1 = *(const f32x4*)(rp + 4); }
                    else { const u32x4 w = *(const u32x4*)((const bf16*)res + off + bj * HALF);
                        r0 = (f32x4){__builtin_bit_cast(float, w.x << 16), __builtin_bit_cast(float, w.x & 0xffff0000u), __builtin_bit_cast(float, w.y << 16), __builtin_bit_cast(float, w.y & 0xffff0000u)};
                        r1 = (f32x4){__builtin_bit_cast(float, w.z << 16), __builtin_bit_cast(float, w.z & 0xffff0000u), __builtin_bit_cast(float, w.w << 16), __builtin_bit_cast(float, w.w & 0xffff0000u)}; }
                    const f32x4 v0 = SCALED ? r0 + acc[ai][bj][m][0] * scale : r0 + acc[ai][bj][m][0], v1 = SCALED ? r1 + acc[ai][bj][m][1] * scale : r1 + acc[ai][bj][m][1];
                    u32x4 o; o.x = cvt_pk_bf16(v0[0], v0[1]); o.y = cvt_pk_bf16(v0[2], v0[3]); o.z = cvt_pk_bf16(v1[0], v1[1]); o.w = cvt_pk_bf16(v1[2], v1[3]);
                    *(u32x4*)(hb + off + bj * HALF) = o; } }
    }
};
struct EpiStoreBf16S {
    static constexpr bool PERM = true;
    bf16* O; int ldc; int prow0; bf16* O2; int split_row; float scale;
    DI void operator()(const f32x4 (&acc)[2][2][4][2], const Unit& u, int wr, int wc, int fr, int fq) const {
        int rowt = (u.pm + prow0) * BM; bf16* base = O; if (O2 && rowt >= split_row) { base = O2; rowt -= split_row; }
        const int row0 = rowt + wr * 64 + fr, col0 = u.pn * BM + wc * 32 + 8 * fq;
#pragma unroll
        for (int ai = 0; ai < 2; ++ai)
#pragma unroll
            for (int m = 0; m < 4; ++m) { bf16* rowp = base + (size_t)(row0 + ai * HALF + m * 16) * ldc + col0;
#pragma unroll
                for (int bj = 0; bj < 2; ++bj) { const f32x4 v0 = acc[ai][bj][m][0] * scale, v1 = acc[ai][bj][m][1] * scale;
                    u32x4 w; w.x = cvt_pk_bf16(v0[0], v0[1]); w.y = cvt_pk_bf16(v0[2], v0[3]); w.z = cvt_pk_bf16(v1[0], v1[1]); w.w = cvt_pk_bf16(v1[2], v1[3]);
                    *(u32x4*)(rowp + bj * HALF) = w; } }
    }
};
struct EpiSwigluS {
    static constexpr bool PERM = true;
    bf16* Hd; int ldc; float ascale;
    DI void operator()(const f32x4 (&acc)[2][2][4][2], const Unit& u, int wr, int wc, int fr, int fq) const {
        const int row0 = u.pm * BM + wr * 64 + fr, col0 = u.pn * HALF + wc * 32 + 8 * fq;
#pragma unroll
        for (int ai = 0; ai < 2; ++ai)
#pragma unroll
            for (int m = 0; m < 4; ++m) { bf16* rowp = Hd + (size_t)(row0 + ai * HALF + m * 16) * ldc + col0;
                float h[8];
#pragma unroll
                for (int n = 0; n < 2; ++n)
#pragma unroll
                    for (int e = 0; e < 4; ++e) { const float g = acc[ai][0][m][n][e] * ascale, up = acc[ai][1][m][n][e] * ascale; h[n * 4 + e] = g * __builtin_amdgcn_rcpf(1.0f + __expf(-g)) * up; }
                u32x4 w; w.x = cvt_pk_bf16(h[0], h[1]); w.y = cvt_pk_bf16(h[2], h[3]); w.z = cvt_pk_bf16(h[4], h[5]); w.w = cvt_pk_bf16(h[6], h[7]);
                *(u32x4*)rowp = w; }
    }
};
struct EpiSwigluF8 {
    static constexpr bool PERM = true;
    unsigned char* Hd; int ldc; float ascale, hscale;
    DI void operator()(const f32x4 (&acc)[2][2][4][2], const Unit& u, int wr, int wc, int fr, int fq) const {
        const int row0 = u.pm * BM + wr * 64 + fr, col0 = u.pn * HALF + wc * 32 + 8 * fq;
        const float c1 = -1.4426950408889634f * ascale, k2 = 1.0f / (ascale * ascale * hscale);
#pragma unroll
        for (int ai = 0; ai < 2; ++ai)
#pragma unroll
            for (int m = 0; m < 4; ++m) { unsigned char* rowp = Hd + (size_t)(row0 + ai * HALF + m * 16) * ldc + col0;
                float h[8];
#pragma unroll
                for (int n = 0; n < 2; ++n)
#pragma unroll
                    for (int e = 0; e < 4; ++e) { const float ag = acc[ai][0][m][n][e], au = acc[ai][1][m][n][e];
                        h[n * 4 + e] = (ag * au) * __builtin_amdgcn_rcpf(__builtin_fmaf(__builtin_amdgcn_exp2f(ag * c1), k2, k2)); }
                u32x2 w; w.x = pk_fp8x4(h[0], h[1], h[2], h[3]); w.y = pk_fp8x4(h[4], h[5], h[6], h[7]);
                *(u32x2*)rowp = w; }
    }
};
struct EpiSwiglu {
    static constexpr bool PERM = true;
    bf16* Hd; int ldc;
    DI void operator()(const f32x4 (&acc)[2][2][4][2], const Unit& u, int wr, int wc, int fr, int fq) const {
        const int row0 = u.pm * BM + wr * 64 + fr, col0 = u.pn * HALF + wc * 32 + 8 * fq;
#pragma unroll
        for (int ai = 0; ai < 2; ++ai)
#pragma unroll
            for (int m = 0; m < 4; ++m) { bf16* rowp = Hd + (size_t)(row0 + ai * HALF + m * 16) * ldc + col0;
                float h[8];
#pragma unroll
                for (int n = 0; n < 2; ++n)
#pragma unroll
                    for (int e = 0; e < 4; ++e) { const float g = acc[ai][0][m][n][e], up = acc[ai][1][m][n][e]; h[n * 4 + e] = g * __builtin_amdgcn_rcpf(1.0f + __expf(-g)) * up; }
                u32x4 w; w.x = cvt_pk_bf16(h[0], h[1]); w.y = cvt_pk_bf16(h[2], h[3]); w.z = cvt_pk_bf16(h[4], h[5]); w.w = cvt_pk_bf16(h[6], h[7]);
                *(u32x4*)rowp = w; }
    }
};
}
using pg8::pk_fp8x4;

struct Params { const float* in[35]; float* out; unsigned char* ws; int s_lo, s_hi; };
struct Frame {
    LAS unsigned char* lds; volatile LAS unsigned* MISC;
    int tid, lane, wave, vcu, G, gw, NGW, bid;
    const float* const* in; float* out; unsigned char* ws;
};
enum { I_X = 0, I_MIXN, I_WIN, I_LRE, I_LIM, I_LSTEP, I_BRE, I_BIM, I_CRE, I_CIM, I_S5D, I_WGLU, I_BGLU, I_S5N, I_LNG, I_LNB, I_SGUW, I_SGUB, I_GMN,
       I_GCONV, I_ALOG, I_DTB, I_GDNN, I_SCCONV, I_SCN, I_WOUT, I_FFNN, I_FG, I_FU, I_FD, I_ROUT, I_MG, I_MU, I_MD, I_FINN };

constexpr int TR_LDS = 64 * 65 * 4;
DI void tr_block(const float* W, int ld, int scol0, bf16* WT, int K, int drow0, int k0, LAS float* scr, int lane, float f8scale = 0.f) {
    f32x4 v[16];
    const float* src = W + (size_t)(k0 + (lane >> 4)) * ld + scol0 + (lane & 15) * 4;
#pragma unroll
    for (int i = 0; i < 16; ++i) v[i] = *(const f32x4*)(src + (size_t)(4 * i) * ld);
#pragma unroll
    for (int i = 0; i < 16; ++i) { LAS float* d = scr + (4 * i + (lane >> 4)) * 65 + (lane & 15) * 4; d[0] = v[i].x; d[1] = v[i].y; d[2] = v[i].z; d[3] = v[i].w; }
    LDS_WAIT(); asm volatile("" ::: "memory");
    const int c = lane & 7;
#pragma unroll
    for (int j = 0; j < 8; ++j) { const int n = (lane >> 3) + 8 * j; const LAS float* sp = scr + (8 * c) * 65 + n;
        if (f8scale != 0.f) { u32x2 o; o.x = pk_fp8x4(sp[0 * 65] * f8scale, sp[1 * 65] * f8scale, sp[2 * 65] * f8scale, sp[3 * 65] * f8scale);
            o.y = pk_fp8x4(sp[4 * 65] * f8scale, sp[5 * 65] * f8scale, sp[6 * 65] * f8scale, sp[7 * 65] * f8scale);
            *(u32x2*)((unsigned char*)WT + (size_t)(drow0 + n) * K + k0 + 8 * c) = o; }
        else { u32x4 o; o.x = cvtpk(sp[0 * 65], sp[1 * 65]); o.y = cvtpk(sp[2 * 65], sp[3 * 65]); o.z = cvtpk(sp[4 * 65], sp[5 * 65]); o.w = cvtpk(sp[6 * 65], sp[7 * 65]);
            *(u32x4*)(WT + (size_t)(drow0 + n) * K + k0 + 8 * c) = o; } }
    LDS_WAIT(); asm volatile("" ::: "memory");
}
DI void tr_item(int item, const float* W0, const float* W1, int ld, int K, int Nd, bf16* WT, int mode, LAS float* scr, int lane, float f8scale = 0.f) {
    const int nnb = Nd / 64, kb = item / nnb, nb = item % nnb, k0 = kb * 64, r0 = nb * 64;
    const float* W = W0; int scol0 = r0;
    if (mode == 1) scol0 = (r0 < 1792) ? r0 : r0 + 8;
    if (mode == 2) { const int tile = r0 >> 8, w = r0 & 255; W = (w < 128) ? W0 : W1; scol0 = tile * 128 + (w & 127); }
    tr_block(W, ld, scol0, WT, K, r0, k0, scr, lane, f8scale);
}
DI void sincos_pi(float r, float& s, float& c) {
    float sg = 1.f;
    if (r > 1.5707963267948966f) { r = 3.14159265358979f - r; sg = -1.f; } else if (r < -1.5707963267948966f) { r = -3.14159265358979f - r; sg = -1.f; }
    const float x2 = r * r;
    s = r * (1.f + x2 * (-1.f / 6 + x2 * (1.f / 120 + x2 * (-1.f / 5040 + x2 * (1.f / 362880 + x2 * (-1.f / 39916800 + x2 * (1.f / 6227020800.f)))))));
    c = sg * (1.f + x2 * (-0.5f + x2 * (1.f / 24 + x2 * (-1.f / 720 + x2 * (1.f / 40320 + x2 * (-1.f / 3628800 + x2 * (1.f / 479001600 + x2 * (-1.f / 87178291200.f))))))));
}
DI void p0_prologue(Frame& F) {
    LAS float* scr = (LAS float*)(F.lds + F.wave * TR_LDS);
    float* SM = (float*)(F.ws + WS_SMALL);
    constexpr int N_IN = 16 * 40, N_OUT = 16 * 16, N_GU = 16 * 88, N_DN = 44 * 16, N_GLU = 4 * 4;
    constexpr int NITEMS = 2 * N_IN + 2 * N_OUT + N_GU + N_DN + 2 * N_GLU;
    for (int it = F.gw; it < NITEMS; it += F.NGW) {
        int r = it;
        if (r < 2 * N_IN) { const int l = r / N_IN; tr_item(r % N_IN, F.in[I_WIN] + (size_t)l * D * IN_COLS, nullptr, IN_COLS, D, NP, (bf16*)(F.ws + WS_WIN) + (size_t)l * NP * D, 1, scr, F.lane); continue; } r -= 2 * N_IN;
        if (r < 2 * N_OUT) { const int l = r / N_OUT; tr_item(r % N_OUT, F.in[I_WOUT] + (size_t)l * D * D, nullptr, D, D, D, (bf16*)(F.ws + WS_WOUT) + (size_t)l * D * D, 0, scr, F.lane); continue; } r -= 2 * N_OUT;
        if (r < N_GU) { tr_item(r, F.in[I_FG], F.in[I_FU], DFF, D, 2 * DFF, (bf16*)(F.ws + WS_WGU), 2, scr, F.lane, F8_SW); continue; } r -= N_GU;
        if (r < N_DN) { tr_item(r, F.in[I_FD], nullptr, D, DFF, D, (bf16*)(F.ws + WS_WDN), 0, scr, F.lane, F8_SWD); continue; } r -= N_DN;
        { const int l = r / N_GLU; tr_item(r % N_GLU, F.in[I_WGLU] + (size_t)l * 65536, nullptr, 256, 256, 256, (bf16*)(F.ws + WS_WGLU) + (size_t)l * 65536, 0, scr, F.lane); }
    }
    for (int jb = F.vcu; jb < 256; jb += F.G) if (F.tid < 128) {
        const int j = jb * 128 + F.tid, i = j >> 4, q = j & 15;
        const int lg = i >> 6;
        const float dt = __expf(F.in[I_LSTEP][lg]);
        const float lr = F.in[I_LRE][i], li = F.in[I_LIM][i];
        const float br = F.in[I_BRE][(size_t)i * 16 + q], bi = F.in[I_BIM][(size_t)i * 16 + q];
        const float mag = __expf(lr * dt); const float ang = li * dt;
        const float rr = ang - 6.283185307179586f * rintf(ang * 0.15915494309189535f);
        float sn, cs; sincos_pi(rr, sn, cs);
        const float ar = mag * cs, ai = mag * sn;
        const float den = lr * lr + li * li;
        const float fr = ((ar - 1.f) * lr + ai * li) / den, fi = (ai * lr - (ar - 1.f) * li) / den;
        SM[SM_BBR + (size_t)i * 16 + q] = fr * br - fi * bi; SM[SM_BBI + (size_t)i * 16 + q] = fr * bi + fi * br;
        if (q == 0) {
            float pr = ar, pi = ai;
#pragma unroll
            for (int k = 0; k < 7; ++k) { const float t = pr * pr - pi * pi; pi = 2.f * pr * pi; pr = t; }
            SM[SM_AR + i] = ar; SM[SM_AI + i] = ai; SM[SM_PR + i] = pr; SM[SM_PI + i] = pi;
        }
    }
    const int gt = F.vcu * NTHR + F.tid, NGT = F.G * NTHR;
    { bf16* SGW = (bf16*)(F.ws + WS_SGW);
      for (int i = gt; i < 2 * 4 * 128 * 128; i += NGT) { const int tt = (i >> 7) & 127, ss = i & 127; SGW[i] = (bf16)f2bf(ss <= tt ? F.in[I_SGUW][i] : 0.f); } }
}

DI void p0_moe_weights(Frame& F) {
    LAS float* scr = (LAS float*)(F.lds + F.wave * TR_LDS);
    constexpr int N_MGU = 16 * 112, N_MDN = 56 * 16;
    for (int it = F.gw; it < 8 * N_MGU + 8 * N_MDN; it += F.NGW) {
        int r = it;
        if (r < 8 * N_MGU) { const int e = r / N_MGU; tr_item(r % N_MGU, F.in[I_MG] + (size_t)e * D * DFE, F.in[I_MU] + (size_t)e * D * DFE, DFE, D, 2 * DFE, (bf16*)(F.ws + WS_MGU + (size_t)e * 2 * DFE * D), 2, scr, F.lane, F8_SW); continue; } r -= 8 * N_MGU;
        { const int e = r / N_MDN; tr_item(r % N_MDN, F.in[I_MD] + (size_t)e * DFE * D, nullptr, D, DFE, D, (bf16*)(F.ws + WS_MDN + (size_t)e * D * DFE), 0, scr, F.lane, F8_SWD); }
    }
}
template <bool XBF> struct RowRaw;
template <> struct RowRaw<false> { f32x4 r[4];
    DI void load(const void* x, size_t row, int lane) { const f32x4* p = (const f32x4*)((const float*)x + row * D) + lane;
#pragma unroll
        for (int j = 0; j < 4; ++j) r[j] = p[64 * j]; }
    DI f32x4 get(int j) const { return r[j]; } };
template <> struct RowRaw<true> { u32x2 r[4];
    DI void load(const void* x, size_t row, int lane) { const u32x2* p = (const u32x2*)((const bf16*)x + row * D) + lane;
#pragma unroll
        for (int j = 0; j < 4; ++j) r[j] = p[64 * j]; }
    DI f32x4 get(int j) const { return (f32x4){bf2f(r[j].x & 0xffffu), bf2f(r[j].x >> 16), bf2f(r[j].y & 0xffffu), bf2f(r[j].y >> 16)}; } };
template <int MODE, bool XBF> DI void norm_phase(Frame& F, const void* x, const float* gain, int l) {
    bf16* H = (bf16*)F.out;
    LAS int* lc = (LAS int*)F.lds;
    f32x4 gv[4];
#pragma unroll
    for (int j = 0; j < 4; ++j) gv[j] = *(const f32x4*)(gain + 4 * F.lane + 256 * j);
    f32x4 wr[8][4];
    if (MODE == 0 || MODE == 2) {
#pragma unroll
        for (int j = 0; j < 4; ++j)
#pragma unroll
            for (int c = 0; c < 4; ++c) { const int d = 4 * F.lane + 256 * j + c;
                const float* src = (MODE == 0) ? F.in[I_WIN] + ((size_t)l * D + d) * IN_COLS + 1792 : F.in[I_ROUT] + (size_t)d * 8;
                const f32x4 w0 = *(const f32x4*)src, w1 = *(const f32x4*)(src + 4); const float g = gv[j][c];
                wr[0][j][c] = w0.x * g; wr[1][j][c] = w0.y * g; wr[2][j][c] = w0.z * g; wr[3][j][c] = w0.w * g; wr[4][j][c] = w1.x * g; wr[5][j][c] = w1.y * g; wr[6][j][c] = w1.z * g; wr[7][j][c] = w1.w * g; }
    }
    for (int blk = F.vcu; blk < T / 128; blk += F.G) {
        if (MODE == 2) { if (F.tid < 8) lc[F.tid] = 0; __syncthreads(); }
        constexpr int NPF = XBF ? 4 : 2;
        RowRaw<XBF> vn[NPF];
#pragma unroll
        for (int k = 0; k < NPF; ++k) vn[k].load(x, (size_t)(blk * 128 + F.wave + 8 * k), F.lane);
#pragma unroll NPF
        for (int k = 0; k < 16; ++k) {
            const int m = blk * 128 + F.wave + 8 * k;
            f32x4 v[4]; float s = 0.f;
#pragma unroll
            for (int j = 0; j < 4; ++j) v[j] = vn[k % NPF].get(j);
            vn[k % NPF].load(x, (size_t)(m + (k < 16 - NPF ? 8 * NPF : 0)), F.lane);
#pragma unroll
            for (int j = 0; j < 4; ++j) s += (v[j].x * v[j].x + v[j].y * v[j].y) + (v[j].z * v[j].z + v[j].w * v[j].w);
            const float rstd = rsqf_(wave_sum(s) * (1.f / D) + EPS);
            if (MODE == 1 || MODE == 2) {
                unsigned* o4 = (unsigned*)((unsigned char*)H + (size_t)m * D) + F.lane;
#pragma unroll
                for (int j = 0; j < 4; ++j) { const f32x4 h = v[j] * (rstd * F8_SA) * gv[j]; o4[64 * j] = pk_fp8x4(h.x, h.y, h.z, h.w); }
            } else {
            unsigned long long* o8 = (unsigned long long*)(H + (size_t)m * D) + F.lane;
#pragma unroll
            for (int j = 0; j < 4; ++j) { const f32x4 h = v[j] * rstd * gv[j]; o8[64 * j] = (unsigned long long)cvtpk(h.x, h.y) | ((unsigned long long)cvtpk(h.z, h.w) << 32); }
            }
            if (MODE == 0 || MODE == 2) {
                float d8[8];
#pragma unroll
                for (int e = 0; e < 8; ++e) { float a = 0.f;
#pragma unroll
                    for (int j = 0; j < 4; ++j) a += (v[j].x * wr[e][j].x + v[j].y * wr[e][j].y) + (v[j].z * wr[e][j].z + v[j].w * wr[e][j].w);
                    d8[e] = wave_sum(a) * rstd; }
                if (MODE == 0) {
                    if (F.lane == 0) { float* ab = (float*)(F.ws + WS_MISC + MS_AB) + (size_t)m * 8; *(f32x4*)ab = (f32x4){d8[0], d8[1], d8[2], d8[3]}; *(f32x4*)(ab + 4) = (f32x4){d8[4], d8[5], d8[6], d8[7]}; }
                } else {
                    int e0 = 0; float l0 = d8[0];
#pragma unroll
                    for (int e = 1; e < 8; ++e) if (d8[e] > l0) { l0 = d8[e]; e0 = e; }
                    int e1 = -1; float l1 = -3.0e38f;
#pragma unroll
                    for (int e = 0; e < 8; ++e) if (e != e0 && d8[e] > l1) { l1 = d8[e]; e1 = e; }
                    const float g0 = 1.0f / (1.0f + __expf(l1 - l0));
                    if (F.lane == 0) { int* te = (int*)(F.ws + WS_MISC + MS_TE) + (size_t)m * 2; te[0] = e0; te[1] = e1; float* tg = (float*)(F.ws + WS_MISC + MS_TG) + (size_t)m * 2; tg[0] = g0; tg[1] = 1.0f - g0;
                        __hip_atomic_fetch_add(&lc[e0], 1, __ATOMIC_RELAXED, __HIP_MEMORY_SCOPE_WORKGROUP); __hip_atomic_fetch_add(&lc[e1], 1, __ATOMIC_RELAXED, __HIP_MEMORY_SCOPE_WORKGROUP); }
                }
            }
        }
        if (MODE == 2) { __syncthreads(); if (F.tid < 8) ((int*)(F.ws + WS_MISC + MS_CNT))[blk * 8 + F.tid] = lc[F.tid]; __syncthreads(); }
    }
}

DI void shortconv_phase(Frame& F, int l, int wg0, int nwg) {
    const bf16* P = (const bf16*)(F.ws + WS_A); bf16* Y = (bf16*)(F.ws + WS_B);
    const float* cw = F.in[I_SCCONV] + l * 768; const float* gn = F.in[I_SCN] + l * 256;
    const int c = F.lane * 4;
    float w[3][4], g4[4];
#pragma unroll
    for (int j = 0; j < 3; ++j)
#pragma unroll
        for (int e = 0; e < 4; ++e) w[j][e] = cw[j * 256 + c + e];
#pragma unroll
    for (int e = 0; e < 4; ++e) g4[e] = gn[c + e];
    for (int half = 0; half < 2; ++half) {
        const int r0 = wg0 * 128 + F.wave * 16 + half * 8, tl = r0 & (SEQ - 1);
        u32x2 cc[10], xx[10], bb[8];
#pragma unroll
        for (int i = 0; i < 10; ++i) { const int m = (tl - 2 + i >= 0) ? r0 - 2 + i : r0;
            cc[i] = *(const u32x2*)(P + (size_t)m * NP + PC_SCC + c); xx[i] = *(const u32x2*)(P + (size_t)m * NP + PC_SCX + c); }
#pragma unroll
        for (int i = 0; i < 8; ++i) bb[i] = *(const u32x2*)(P + (size_t)(r0 + i) * NP + PC_SCB + c);
        float cx[10][4];
#pragma unroll
        for (int i = 0; i < 10; ++i) { const float z = (tl - 2 + i >= 0) ? 1.f : 0.f;
            cx[i][0] = z * bf2f(cc[i].x & 0xffffu) * bf2f(xx[i].x & 0xffffu); cx[i][1] = z * bf2f(cc[i].x >> 16) * bf2f(xx[i].x >> 16);
            cx[i][2] = z * bf2f(cc[i].y & 0xffffu) * bf2f(xx[i].y & 0xffffu); cx[i][3] = z * bf2f(cc[i].y >> 16) * bf2f(xx[i].y >> 16); }
#pragma unroll
        for (int i = 0; i < 8; ++i) {
            const int m = r0 + i;
            float acc[4];
#pragma unroll
            for (int e = 0; e < 4; ++e) acc[e] = w[0][e] * cx[i][e] + w[1][e] * cx[i + 1][e] + w[2][e] * cx[i + 2][e];
            float o[4] = {acc[0] * bf2f(bb[i].x & 0xffffu), acc[1] * bf2f(bb[i].x >> 16), acc[2] * bf2f(bb[i].y & 0xffffu), acc[3] * bf2f(bb[i].y >> 16)};
            const float ss = wave_sum((o[0] * o[0] + o[1] * o[1]) + (o[2] * o[2] + o[3] * o[3]));
            const float r = rsqf_(ss * (1.f / 256) + EPS);
            u32x2 ov; ov.x = pk2(o[0] * r * g4[0], o[1] * r * g4[1]); ov.y = pk2(o[2] * r * g4[2], o[3] * r * g4[3]);
            *(u32x2*)(Y + (size_t)m * D + 768 + c) = ov;
        }
    }
}
constexpr int GM_SV = 136;
DI void gmlp_phase(Frame& F, int l, int wg0, int nwg) {
    const bf16* P = (const bf16*)(F.ws + WS_A); bf16* Y = (bf16*)(F.ws + WS_B);
    LAS bf16* vT = (LAS bf16*)F.lds;
    LAS float* part = (LAS float*)(F.lds + 69632);
    const float* lng = F.in[I_LNG] + l * 256; const float* lnb = F.in[I_LNB] + l * 256; const float* gn = F.in[I_GMN] + l * 256;
    const bf16* wb = (const bf16*)(F.ws + WS_SGW) + (size_t)l * 4 * 128 * 128; const float* sb = F.in[I_SGUB] + l * 512;
    const int l15 = F.lane & 15, qd = F.lane >> 4, h = F.wave >> 1, half = F.wave & 1;
    for (int ch = wg0; ch < T / 128; ch += nwg) {
        const int t0 = ch * 128;
        { const int c = F.lane * 4;
          const f32x4 g4 = *(const f32x4*)(lng + c), b4 = *(const f32x4*)(lnb + c);
          u32x2 pv16[16];
#pragma unroll
          for (int k = 0; k < 16; ++k) pv16[k] = *(const u32x2*)(P + (size_t)(t0 + F.wave + NWAVES * k) * NP + PC_GV + c);
#pragma unroll
          for (int k = 0; k < 16; ++k) { const int s = F.wave + NWAVES * k;
            const u32x2 pv = pv16[k];
            float z[4] = {gelu_tanh(bf2f(pv.x & 0xffffu)), gelu_tanh(bf2f(pv.x >> 16)), gelu_tanh(bf2f(pv.y & 0xffffu)), gelu_tanh(bf2f(pv.y >> 16))};
            const float mean = wave_sum((z[0] + z[1]) + (z[2] + z[3])) * (1.f / 256);
            float q2 = 0.f;
#pragma unroll
            for (int e = 0; e < 4; ++e) { z[e] -= mean; q2 += z[e] * z[e]; }
            const float r = rsqf_(wave_sum(q2) * (1.f / 256) + EPS);
#pragma unroll
            for (int e = 0; e < 4; ++e) vT[(c + e) * GM_SV + s] = (bf16)f2bf(z[e] * r * g4[e] + b4[e]);
          } }
        unsigned short ur[4][4][4]; float bs[4][4];
#pragma unroll
        for (int i = 0; i < 4; ++i)
#pragma unroll
            for (int rr = 0; rr < 4; ++rr) { const int t = 16 * (half + 2 * i) + 4 * qd + rr; bs[i][rr] = sb[h * 128 + t];
#pragma unroll
                for (int nt = 0; nt < 4; ++nt) ur[i][rr][nt] = P[(size_t)(t0 + t) * NP + PC_GU + 64 * h + 16 * nt + l15]; }
        __syncthreads();
        f32x4 acc[4][4];
#pragma unroll
        for (int i = 0; i < 4; ++i)
#pragma unroll
            for (int nt = 0; nt < 4; ++nt) acc[i][nt] = (f32x4){0.f, 0.f, 0.f, 0.f};
#pragma unroll
        for (int i = 0; i < 4; ++i) {
            const int tt = half + 2 * i;
#pragma unroll
            for (int ks = 0; ks < 4; ++ks) {
                if (32 * ks <= 16 * tt + 15) {
                    const bf16x8 af = *(const bf16x8*)(wb + ((size_t)h * 128 + 16 * tt + l15) * 128 + 32 * ks + 8 * qd);
#pragma unroll
                    for (int nt = 0; nt < 4; ++nt) { const bf16x8 bf = *(const LAS bf16x8*)(vT + (64 * h + 16 * nt + l15) * GM_SV + 32 * ks + 8 * qd);
                        acc[i][nt] = __builtin_amdgcn_mfma_f32_16x16x32_bf16(af, bf, acc[i][nt], 0, 0, 0); }
                }
            }
        }
#pragma unroll
        for (int i = 0; i < 4; ++i)
#pragma unroll
            for (int rr = 0; rr < 4; ++rr) { const int t = 16 * (half + 2 * i) + 4 * qd + rr; const float bias = bs[i][rr]; float ss = 0.f;
#pragma unroll
                for (int nt = 0; nt < 4; ++nt) { const float u = gelu_tanh(bf2f(ur[i][rr][nt])); const float o = u * (acc[i][nt][rr] + bias); acc[i][nt][rr] = o; ss += o * o; }
                ss = row_sum16(ss);
                if (l15 == 0) part[t * 4 + h] = ss; }
        __syncthreads();
#pragma unroll
        for (int i = 0; i < 4; ++i)
#pragma unroll
            for (int rr = 0; rr < 4; ++rr) { const int t = 16 * (half + 2 * i) + 4 * qd + rr; const f32x4 pp = *(const LAS f32x4*)(part + t * 4);
                const float r = rsqf_(((pp.x + pp.y) + (pp.z + pp.w)) * (1.f / 256) + EPS);
#pragma unroll
                for (int nt = 0; nt < 4; ++nt) { const int cc = 64 * h + 16 * nt + l15; Y[(size_t)(t0 + t) * D + 256 + cc] = (bf16)f2bf(acc[i][nt][rr] * r * gn[cc]); } }
        __syncthreads();
    }
}
DI int gkk(int s, int q, int j) { return 32 * s + 16 * (j >> 2) + 4 * q + (j & 3); }
template <int PART, int R0, int NR> DI void gdn_conv_rows(const bf16* P, const float* cw, size_t t0, int n, int h, int lane, float (&y)[64], LAS bf16* tile) {
    const int ch = PART * 256 + h * 64 + lane;
    const float w0 = cw[0 * 768 + ch], w1 = cw[1 * 768 + ch], w2 = cw[2 * 768 + ch], w3 = cw[3 * 768 + ch];
    const bf16* src = P + (t0 + R0) * NP + PC_Q + ch;
    float p0 = 0.f, p1 = 0.f, p2 = 0.f;
    if (R0 > 0 || n > 0) { p0 = bf2f(*(src - 3 * (ptrdiff_t)NP)); p1 = bf2f(*(src - 2 * (ptrdiff_t)NP)); p2 = bf2f(*(src - (ptrdiff_t)NP)); }
    constexpr int CB = NR;
#pragma unroll
    for (int hb = 0; hb < NR / CB; ++hb) {
        unsigned short raw16[CB];
#pragma unroll
        for (int i = 0; i < CB; ++i) raw16[i] = *(const unsigned short*)(src + (size_t)(hb * CB + i) * NP);
        float raw[CB];
#pragma unroll
        for (int i = 0; i < CB; ++i) raw[i] = bf2f(raw16[i]);
#pragma unroll
        for (int i = 0; i < CB; ++i) {
            const float cur = raw[i];
            float v = siluf_(w0 * p0 + w1 * p1 + w2 * p2 + w3 * cur);
            p0 = p1; p1 = p2; p2 = cur;
            if (PART < 2) { const float ss = wave_sum(v * v); v *= (PART == 0 ? 0.125f : 1.0f) * rsqf_(ss + EPS); }
            if (PART > 0) y[R0 + hb * CB + i] = v;
            if (PART < 2) tile[(R0 + hb * CB + i) * 72 + lane] = (bf16)f2bf(v);
        }
    }
}
DI void gdn_prep_phase(Frame& F, int l) {
    const bf16* P = (const bf16*)(F.ws + WS_A); const float* AB = (const float*)(F.ws + WS_MISC + MS_AB); unsigned char* GOP = F.ws + WS_GOP; const float* cw = F.in[I_GCONV] + (size_t)l * 4 * 768;
    const int h = F.wave & 3, r = F.wave >> 2, lane = F.lane, l15 = lane & 15, q = lane >> 4;
    LAS unsigned char* hb = F.lds + h * 36608;
    LAS bf16* kt = (LAS bf16*)hb; LAS bf16* qt = (LAS bf16*)(hb + 9216); LAS float* At = (LAS float*)(hb + 18432);
    LAS float* Gs = (LAS float*)(hb + 18432 + 17408); LAS float* Bs = Gs + 64; LAS float* Es = Gs + 128;
    for (int item = F.vcu; item < NB * 128; item += F.G) {
        const int b = item >> 7, n = item & 127; const size_t t0 = (size_t)b * SEQ + (size_t)n * 64;
        unsigned char* ob = GOP + (size_t)((b * 4 + h) * 128 + n) * GOP_ISTRIDE;
        float x[64];
        if (r) { gdn_conv_rows<1, 0, 64>(P, cw, t0, n, h, lane, x, kt); gdn_conv_rows<0, 32, 32>(P, cw, t0, n, h, lane, x, qt); }
        else { gdn_conv_rows<2, 0, 64>(P, cw, t0, n, h, lane, x, kt); gdn_conv_rows<0, 0, 32>(P, cw, t0, n, h, lane, x, qt); }
        { const float av = AB[(t0 + lane) * 8 + h], bv = AB[(t0 + lane) * 8 + 4 + h];
          float g = -__expf(F.in[I_ALOG][l * 4 + h]) * softplusf_(av + F.in[I_DTB][l * 4 + h]); const float beta = sigmoidf_(bv);
#pragma unroll
          for (int o = 1; o < 64; o <<= 1) { const float t = __shfl_up(g, o); if (lane >= o) g += t; }
          if (r) { Gs[lane] = g; Bs[lane] = beta; Es[lane] = beta * __expf(g); } }
        __syncthreads();
        bf16x8 kf[4][2];
#pragma unroll
        for (int a = 0; a < 4; ++a)
#pragma unroll
            for (int s2 = 0; s2 < 2; ++s2) kf[a][s2] = *(const LAS bf16x8*)(kt + (16 * a + l15) * 72 + 32 * s2 + 8 * q);
        if (r) {
#pragma unroll
            for (int a = 0; a < 4; ++a)
#pragma unroll
                for (int bb = 0; bb <= a; ++bb) {
                    f32x4 d = (f32x4){0.f, 0.f, 0.f, 0.f};
                    d = __builtin_amdgcn_mfma_f32_16x16x32_bf16(kf[a][0], kf[bb][0], d, 0, 0, 0);
                    d = __builtin_amdgcn_mfma_f32_16x16x32_bf16(kf[a][1], kf[bb][1], d, 0, 0, 0);
                    const int j = 16 * bb + l15; const float gj = Gs[j];
#pragma unroll
                    for (int rr = 0; rr < 4; ++rr) { const int i = 16 * a + 4 * q + rr; At[i * 68 + j] = (j < i) ? Bs[i] * d[rr] * __expf(Gs[i] - gj) : 0.f; }
                }
            const float g63 = Gs[63];
#pragma unroll
            for (int t = 0; t < 4; ++t)
#pragma unroll
                for (int s2 = 0; s2 < 2; ++s2) { float e[8];
#pragma unroll
                    for (int j = 0; j < 8; ++j) { const int c = gkk(s2, q, j); e[j] = bf2f(kt[c * 72 + 16 * t + l15]) * __expf(g63 - Gs[c]); }
                    u32x4 w; w.x = cvtpk(e[0], e[1]); w.y = cvtpk(e[2], e[3]); w.z = cvtpk(e[4], e[5]); w.w = cvtpk(e[6], e[7]);
                    *(u32x4*)(ob + 8192 + (t * 2 + s2) * 1024 + lane * 16) = w; }
            if (lane == 0) *(float*)(ob + 49152) = __expf(g63);
        } else {
#pragma unroll
            for (int i = 0; i < 4; ++i) {
                const bf16x8 qf0 = *(const LAS bf16x8*)(qt + (16 * i + l15) * 72 + 8 * q), qf1 = *(const LAS bf16x8*)(qt + (16 * i + l15) * 72 + 32 + 8 * q);
                const int c = 16 * i + l15; const float gc = Gs[c];
                float v[4][4];
#pragma unroll
                for (int a = 0; a < 4; ++a) {
                    if (a <= i) { f32x4 d = (f32x4){0.f, 0.f, 0.f, 0.f};
                        d = __builtin_amdgcn_mfma_f32_16x16x32_bf16(kf[a][0], qf0, d, 0, 0, 0);
                        d = __builtin_amdgcn_mfma_f32_16x16x32_bf16(kf[a][1], qf1, d, 0, 0, 0);
#pragma unroll
                        for (int rr = 0; rr < 4; ++rr) { const int cp = 16 * a + 4 * q + rr; v[a][rr] = (cp <= c) ? d[rr] * __expf(gc - Gs[cp]) : 0.f; }
                    } else {
#pragma unroll
                        for (int rr = 0; rr < 4; ++rr) v[a][rr] = 0.f; }
                }
#pragma unroll
                for (int s2 = 0; s2 < 2; ++s2) { u32x4 w; w.x = cvtpk(v[2 * s2][0], v[2 * s2][1]); w.y = cvtpk(v[2 * s2][2], v[2 * s2][3]); w.z = cvtpk(v[2 * s2 + 1][0], v[2 * s2 + 1][1]); w.w = cvtpk(v[2 * s2 + 1][2], v[2 * s2 + 1][3]);
                    *(u32x4*)(ob + 24576 + (i * 2 + s2) * 1024 + lane * 16) = w; }
                const float eg = __expf(gc);
#pragma unroll
                for (int s2 = 0; s2 < 2; ++s2) { const u32x2 a0 = *(const LAS u32x2*)(qt + c * 72 + 32 * s2 + 4 * q), a1 = *(const LAS u32x2*)(qt + c * 72 + 32 * s2 + 16 + 4 * q);
                    u32x4 w; w.x = cvtpk(bf2f(a0.x & 0xffffu) * eg, bf2f(a0.x >> 16) * eg); w.y = cvtpk(bf2f(a0.y & 0xffffu) * eg, bf2f(a0.y >> 16) * eg);
                    w.z = cvtpk(bf2f(a1.x & 0xffffu) * eg, bf2f(a1.x >> 16) * eg); w.w = cvtpk(bf2f(a1.y & 0xffffu) * eg, bf2f(a1.y >> 16) * eg);
                    *(u32x4*)(ob + 16384 + (i * 2 + s2) * 1024 + lane * 16) = w; }
            }
        }
        __syncthreads();
        { LAS float* cf = r ? Es : Bs;
#pragma unroll
          for (int i = 0; i < 64; ++i) {
              float a0 = x[i] * cf[i], a1 = 0.f, a2 = 0.f, a3 = 0.f;
#pragma unroll
              for (int jb = 0; jb < (i + 3) / 4; ++jb) { const f32x4 a4 = *(const LAS f32x4*)(At + i * 68 + 4 * jb);
                  if (4 * jb + 0 < i) a0 -= a4[0] * x[4 * jb + 0];
                  if (4 * jb + 1 < i) a1 -= a4[1] * x[4 * jb + 1];
                  if (4 * jb + 2 < i) a2 -= a4[2] * x[4 * jb + 2];
                  if (4 * jb + 3 < i) a3 -= a4[3] * x[4 * jb + 3]; }
              x[i] = (a0 + a1) + (a2 + a3); } }
        if (r == 0) {
            float* wv = (float*)(ob + 32768); const int sl = lane >> 4, vl = lane & 15;
#pragma unroll
            for (int c = 0; c < 64; ++c) wv[((sl * 4 + (c >> 4)) * 64 + vl + 16 * ((c >> 2) & 3)) * 4 + (c & 3)] = x[c];
        } else {
#pragma unroll
            for (int c = 0; c < 64; ++c) kt[c * 72 + lane] = (bf16)f2bf(-x[c]);
            LDS_WAIT(); __builtin_amdgcn_wave_barrier();
#pragma unroll
            for (int i = 0; i < 4; ++i)
#pragma unroll
                for (int s2 = 0; s2 < 2; ++s2) { const int c = 16 * i + l15; const u32x2 a0 = *(const LAS u32x2*)(kt + c * 72 + 32 * s2 + 4 * q), a1 = *(const LAS u32x2*)(kt + c * 72 + 32 * s2 + 16 + 4 * q);
                    u32x4 w; w.x = a0.x; w.y = a0.y; w.z = a1.x; w.w = a1.y; *(u32x4*)(ob + (i * 2 + s2) * 1024 + lane * 16) = w; }
        }
        __syncthreads();
    }
}
DI void gdn_scan_phase(Frame& F, int l) {
    if (F.vcu >= 64) return;
    const int bh = F.vcu >> 2, sl = F.vcu & 3, b = bh >> 2, h = bh & 3, lane = F.lane, l15 = lane & 15, q = lane >> 4;
    const unsigned char* gsrc = F.ws + WS_GOP + (size_t)bh * 128 * GOP_ISTRIDE;
    bf16* O = (bf16*)(F.ws + WS_GO);
    constexpr int SLOT = 37 * 1024;
    const int w = F.wave;
#define GDN_ISSUE(n_) do { const unsigned char* cs_ = gsrc + (size_t)(n_) * GOP_ISTRIDE; LAS unsigned char* sd_ = F.lds + ((n_) & 3) * SLOT; \
        for (int p_ = w - 1; p_ < 37; p_ += 7) { const int so_ = (p_ < 32) ? p_ * 1024 : (p_ < 36) ? 32768 + sl * 4096 + (p_ - 32) * 1024 : 49152; \
            __builtin_amdgcn_global_load_lds((const unsigned*)(cs_ + so_ + lane * 16), (LAS unsigned*)(sd_ + p_ * 1024), 16, 0, 0); } } while (0)
    if (w > 0) { GDN_ISSUE(0); GDN_ISSUE(1); GDN_ISSUE(2); }
    f32x4 S[4];
#pragma unroll
    for (int t = 0; t < 4; ++t) S[t] = (f32x4){0.f, 0.f, 0.f, 0.f};
    for (int n = 0; n < 128; ++n) {
        if (w > 0) {
            if (n == 127) { asm volatile("s_waitcnt vmcnt(0)" ::: "memory"); }
            else if (n == 126) { if (w <= 2) { asm volatile("s_waitcnt vmcnt(6)" ::: "memory"); } else { asm volatile("s_waitcnt vmcnt(5)" ::: "memory"); } }
            else if (w <= 2) { asm volatile("s_waitcnt vmcnt(12)" ::: "memory"); } else { asm volatile("s_waitcnt vmcnt(10)" ::: "memory"); } }
        asm volatile("s_waitcnt lgkmcnt(0)" ::: "memory");
        __builtin_amdgcn_s_barrier();
        asm volatile("" ::: "memory");
        if (w > 0) { if (n + 3 < 128) GDN_ISSUE(n + 3); }
        else {
            const LAS unsigned char* sd = F.lds + (n & 3) * SLOT;
            f32x4 wv[4]; bf16x8 fr[4][8];
#pragma unroll
            for (int i = 0; i < 4; ++i) wv[i] = *(const LAS f32x4*)(sd + 32768 + i * 1024 + lane * 16);
#pragma unroll
            for (int blk = 0; blk < 4; ++blk)
#pragma unroll
                for (int f = 0; f < 8; ++f) fr[blk == 1 ? 1 : (blk == 0 ? 0 : blk)][f] = *(const LAS bf16x8*)(sd + blk * 8192 + f * 1024 + lane * 16);
            const float gt = *(const LAS float*)(sd + 36 * 1024);
            __builtin_amdgcn_sched_barrier(0);
#define GFRAG(blk, f) (fr[blk][f])
            u32x4 sf[2], uf[2];
#pragma unroll
            for (int s2 = 0; s2 < 2; ++s2) { sf[s2].x = cvtpk(S[2 * s2][0], S[2 * s2][1]); sf[s2].y = cvtpk(S[2 * s2][2], S[2 * s2][3]); sf[s2].z = cvtpk(S[2 * s2 + 1][0], S[2 * s2 + 1][1]); sf[s2].w = cvtpk(S[2 * s2 + 1][2], S[2 * s2 + 1][3]); }
            f32x4 U[4];
#pragma unroll
            for (int i = 0; i < 4; ++i) { U[i] = wv[i];
                U[i] = __builtin_amdgcn_mfma_f32_16x16x32_bf16(GFRAG(0, i * 2 + 0), __builtin_bit_cast(bf16x8, sf[0]), U[i], 0, 0, 0);
                U[i] = __builtin_amdgcn_mfma_f32_16x16x32_bf16(GFRAG(0, i * 2 + 1), __builtin_bit_cast(bf16x8, sf[1]), U[i], 0, 0, 0); }
#pragma unroll
            for (int s2 = 0; s2 < 2; ++s2) { uf[s2].x = cvtpk(U[2 * s2][0], U[2 * s2][1]); uf[s2].y = cvtpk(U[2 * s2][2], U[2 * s2][3]); uf[s2].z = cvtpk(U[2 * s2 + 1][0], U[2 * s2 + 1][1]); uf[s2].w = cvtpk(U[2 * s2 + 1][2], U[2 * s2 + 1][3]); }
#pragma unroll
            for (int t = 0; t < 4; ++t) { S[t] = S[t] * gt;
                S[t] = __builtin_amdgcn_mfma_f32_16x16x32_bf16(GFRAG(1, t * 2 + 0), __builtin_bit_cast(bf16x8, uf[0]), S[t], 0, 0, 0);
                S[t] = __builtin_amdgcn_mfma_f32_16x16x32_bf16(GFRAG(1, t * 2 + 1), __builtin_bit_cast(bf16x8, uf[1]), S[t], 0, 0, 0); }
            const size_t row0 = (size_t)b * SEQ + (size_t)n * 64;
#pragma unroll
            for (int i = 0; i < 4; ++i) { f32x4 o = (f32x4){0.f, 0.f, 0.f, 0.f};
                o = __builtin_amdgcn_mfma_f32_16x16x32_bf16(GFRAG(2, i * 2 + 0), __builtin_bit_cast(bf16x8, sf[0]), o, 0, 0, 0);
                o = __builtin_amdgcn_mfma_f32_16x16x32_bf16(GFRAG(2, i * 2 + 1), __builtin_bit_cast(bf16x8, sf[1]), o, 0, 0, 0);
                o = __builtin_amdgcn_mfma_f32_16x16x32_bf16(GFRAG(3, i * 2 + 0), __builtin_bit_cast(bf16x8, uf[0]), o, 0, 0, 0);
                o = __builtin_amdgcn_mfma_f32_16x16x32_bf16(GFRAG(3, i * 2 + 1), __builtin_bit_cast(bf16x8, uf[1]), o, 0, 0, 0);
#pragma unroll
                for (int rr = 0; rr < 4; ++rr) O[(row0 + 16 * i + 4 * q + rr) * 256 + h * 64 + sl * 16 + l15] = (bf16)f2bf(o[rr]); }
#undef GFRAG
        }
    }
#undef GDN_ISSUE
    asm volatile("s_waitcnt vmcnt(0) lgkmcnt(0)" ::: "memory");
    __builtin_amdgcn_s_barrier();
}
DI void gdn_finish_phase(Frame& F, int l) {
    const bf16* P = (const bf16*)(F.ws + WS_A); const bf16* O = (const bf16*)(F.ws + WS_GO); bf16* Y = (bf16*)(F.ws + WS_B);
    const int c = F.lane * 4;
    const f32x4 gn = *(const f32x4*)(F.in[I_GDNN] + l * 64 + (c & 63));
    for (int m0 = F.gw; m0 < T; m0 += 4 * F.NGW) {
      u32x2 ov4[4], zv4[4];
#pragma unroll
      for (int r = 0; r < 4; ++r) { const int m = m0 + r * F.NGW; ov4[r] = *(const u32x2*)(O + (size_t)m * 256 + c); zv4[r] = *(const u32x2*)(P + (size_t)m * NP + PC_Z + c); }
#pragma unroll
      for (int r = 0; r < 4; ++r) {
        const int m = m0 + r * F.NGW; const u32x2 ov = ov4[r], zv = zv4[r];
        float o[4] = {bf2f(ov.x & 0xffffu), bf2f(ov.x >> 16), bf2f(ov.y & 0xffffu), bf2f(ov.y >> 16)};
        const float z[4] = {bf2f(zv.x & 0xffffu), bf2f(zv.x >> 16), bf2f(zv.y & 0xffffu), bf2f(zv.y >> 16)};
        float ss = (o[0] * o[0] + o[1] * o[1]) + (o[2] * o[2] + o[3] * o[3]);
        ss = row_sum16(ss);
        const float rs = rsqf_(ss * (1.f / 64) + EPS);
        u32x2 w; w.x = pk2(o[0] * rs * gn.x * siluf_(z[0]), o[1] * rs * gn.y * siluf_(z[1])); w.y = pk2(o[2] * rs * gn.z * siluf_(z[2]), o[3] * rs * gn.w * siluf_(z[3]));
        *(u32x2*)(Y + (size_t)m * D + 512 + c) = w;
      }
    }
}
constexpr int S5_SS = 136, S5_YS = 264;
struct S5Consts { float ar, ai; bf16x8 bfr[8]; };
DI void s5_load_consts(Frame& F, int l, int g, S5Consts& K) {
    const float* SM = (const float*)(F.ws + WS_SMALL);
    const int si = (l * 16 + g) * 64 + F.lane, l15 = F.lane & 15, qd = F.lane >> 4;
    K.ar = SM[SM_AR + si]; K.ai = SM[SM_AI + si];
#pragma unroll
    for (int nt = 0; nt < 8; ++nt) {
        u32x4 w = (u32x4){0u, 0u, 0u, 0u};
        if (qd < 2) { const int np = 16 * nt + l15; const float* src = SM + ((np < 64) ? SM_BBR : SM_BBI) + (size_t)((l * 16 + g) * 64 + (np & 63)) * 16 + 8 * qd;
            const f32x4 x0 = *(const f32x4*)src, x1 = *(const f32x4*)(src + 4); w.x = cvtpk(x0.x, x0.y); w.y = cvtpk(x0.z, x0.w); w.z = cvtpk(x1.x, x1.y); w.w = cvtpk(x1.z, x1.w); }
        K.bfr[nt] = __builtin_bit_cast(bf16x8, w);
    }
}
DI u32x4 s5_load_u(const bf16* ub, int l15, int qd) {
    const u32x4 v = *(const u32x4*)(ub + (size_t)l15 * NP + 8 * (qd & 1)); const unsigned m = (qd < 2) ? 0xffffffffu : 0u; return (u32x4){v.x & m, v.y & m, v.z & m, v.w & m}; }
constexpr int S5_BT = 48;
template <bool OUT> DI void s5_block16(Frame& F, const S5Consts& K, const u32x4 uw, float& sr, float& sim, LAS unsigned char* scr) {
    const int l15 = F.lane & 15, qd = F.lane >> 4;
    const bf16x8 uf = __builtin_bit_cast(bf16x8, uw);
    f32x4 d[8];
#pragma unroll
    for (int nt = 0; nt < 8; ++nt) d[nt] = __builtin_amdgcn_mfma_f32_16x16x32_bf16(uf, K.bfr[nt], (f32x4){0.f, 0.f, 0.f, 0.f}, 0, 0, 0);
    __builtin_amdgcn_sched_barrier(0);
#pragma unroll
    for (int nt = 0; nt < 8; ++nt) { u32x2 w; w.x = cvtpk(d[nt][0], d[nt][1]); w.y = cvtpk(d[nt][2], d[nt][3]); *(LAS u32x2*)(scr + (16 * nt + l15) * S5_BT + 8 * qd) = w; }
    LDS_WAIT(); __builtin_amdgcn_wave_barrier();
    __builtin_amdgcn_sched_barrier(0);
    unsigned rw[8], iw[8];
    { const u32x4 r0 = *(const LAS u32x4*)(scr + F.lane * S5_BT), r1 = *(const LAS u32x4*)(scr + F.lane * S5_BT + 16);
      const u32x4 i0 = *(const LAS u32x4*)(scr + (64 + F.lane) * S5_BT), i1 = *(const LAS u32x4*)(scr + (64 + F.lane) * S5_BT + 16);
      rw[0] = r0.x; rw[1] = r0.y; rw[2] = r0.z; rw[3] = r0.w; rw[4] = r1.x; rw[5] = r1.y; rw[6] = r1.z; rw[7] = r1.w;
      iw[0] = i0.x; iw[1] = i0.y; iw[2] = i0.z; iw[3] = i0.w; iw[4] = i1.x; iw[5] = i1.y; iw[6] = i1.z; iw[7] = i1.w; }
    LDS_WAIT(); __builtin_amdgcn_wave_barrier();
    float hr[16], hi[16];
#pragma unroll
    for (int t = 0; t < 16; ++t) {
        const float br = __uint_as_float((t & 1) ? (rw[t >> 1] & 0xffff0000u) : (rw[t >> 1] << 16)), bi = __uint_as_float((t & 1) ? (iw[t >> 1] & 0xffff0000u) : (iw[t >> 1] << 16));
        const float nr = K.ar * sr - K.ai * sim + br, ni = K.ar * sim + K.ai * sr + bi; sr = nr; sim = ni;
        hr[t] = sr; hi[t] = sim;
    }
    if (OUT) {
#pragma unroll
        for (int t = 0; t < 16; ++t) *(LAS unsigned*)(scr + t * (S5_SS * 2) + 4 * F.lane) = cvtpk(hr[t], hi[t]);
        LDS_WAIT(); __builtin_amdgcn_wave_barrier();
    }
}
DI void s5_pass1_phase(Frame& F, int l) {
    const bf16* P = (const bf16*)(F.ws + WS_A); float* E = (float*)(F.ws + WS_MISC + MS_E);
    LAS unsigned char* scr = F.lds + F.wave * 8704;
    for (int it = F.gw; it < NB * 16 * S5NC; it += F.NGW) {
        const int c = it % S5NC, g = (it / S5NC) & 15, b = it / (S5NC * 16);
        S5Consts K; s5_load_consts(F, l, g, K);
        float sr = 0.f, sim = 0.f;
        const bf16* up = P + ((size_t)b * SEQ + (size_t)c * S5CS) * NP + PC_S5 + g * 16;
        u32x4 uw8[S5CS / 16];
#pragma unroll
        for (int tb = 0; tb < S5CS / 16; ++tb) uw8[tb] = s5_load_u(up + (size_t)tb * 16 * NP, F.lane & 15, F.lane >> 4);
        asm volatile("s_waitcnt vmcnt(0)" ::: "memory");
#pragma unroll
        for (int tb = 0; tb < S5CS / 16; ++tb) s5_block16<false>(F, K, uw8[tb], sr, sim, scr);
        float* e = E + ((size_t)(b * 16 + g) * S5NC + c) * 128;
        e[F.lane] = sr; e[64 + F.lane] = sim;
    }
}
DI void s5_pass3_phase(Frame& F, int l, int wg0, int nwg) {
    const bf16* P = (const bf16*)(F.ws + WS_A); const float* SM = (const float*)(F.ws + WS_SMALL); const float* E = (const float*)(F.ws + WS_MISC + MS_E); bf16* Y = (bf16*)(F.ws + WS_B);
    LAS bf16* yt = (LAS bf16*)(F.lds + 69632);
    LAS unsigned char* scr = F.lds + F.wave * 8704;
    LAS float* part = (LAS float*)(F.lds + 67584 + 8 * 8704);
    const float* cre = F.in[I_CRE] + (size_t)l * 16 * 16 * 64; const float* cim = F.in[I_CIM] + (size_t)l * 16 * 16 * 64;
    const float* dsk = F.in[I_S5D] + l * 256;
    const int l15 = F.lane & 15, qd = F.lane >> 4;
    for (int it = wg0; it < NB * S5NC; it += nwg) {
        const int b = it / S5NC, c = it % S5NC;
        const size_t row0 = (size_t)b * SEQ + (size_t)c * S5CS;
#pragma unroll 4
        for (int k2 = 0; k2 < 8; ++k2) { const int id = F.tid + NTHR * k2, rw = id >> 5, c16 = id & 31;
            *(LAS u32x4*)(yt + rw * S5_YS + c16 * 8) = *(const u32x4*)(P + (row0 + rw) * NP + PC_S5 + c16 * 8); }
        __syncthreads();
        for (int gi = 0; gi < 2; ++gi) {
            const int g = F.wave * 2 + gi;
            S5Consts K; s5_load_consts(F, l, g, K);
            const int si = (l * 16 + g) * 64 + F.lane;
            const float pr = SM[SM_PR + si], pi = SM[SM_PI + si];
            float sr = 0.f, sim = 0.f;
            const float* e = E + (size_t)(b * 16 + g) * S5NC * 128;
            for (int cc0 = 0; cc0 < c; cc0 += 8) {
                float er[8], ei[8];
#pragma unroll
                for (int k2 = 0; k2 < 8; ++k2) { const int cc = (cc0 + k2 < c) ? cc0 + k2 : c - 1; er[k2] = e[cc * 128 + F.lane]; ei[k2] = e[cc * 128 + 64 + F.lane]; }
#pragma unroll
                for (int k2 = 0; k2 < 8; ++k2) if (cc0 + k2 < c) { const float nr = pr * sr - pi * sim + er[k2], ni = pr * sim + pi * sr + ei[k2]; sr = nr; sim = ni; }
            }
            bf16x8 cfr[4];
#pragma unroll
            for (int s2 = 0; s2 < 4; ++s2) { const size_t o = ((size_t)g * 16 + l15) * 64 + 16 * s2 + 4 * qd; const f32x4 cr = *(const f32x4*)(cre + o), ci = *(const f32x4*)(cim + o);
                u32x4 w; w.x = cvtpk(cr.x, -ci.x); w.y = cvtpk(cr.y, -ci.y); w.z = cvtpk(cr.z, -ci.z); w.w = cvtpk(cr.w, -ci.w); cfr[s2] = __builtin_bit_cast(bf16x8, w); }
            const float dch = dsk[g * 16 + l15];
            const bf16* up = P + row0 * NP + PC_S5 + g * 16;
            for (int tb = 0; tb < S5CS / 16; ++tb) {
                u32x4 uw = *(const LAS u32x4*)(yt + (tb * 16 + l15) * S5_YS + g * 16 + 8 * (qd & 1));
                { const unsigned msk = (qd < 2) ? 0xffffffffu : 0u; uw.x &= msk; uw.y &= msk; uw.z &= msk; uw.w &= msk; }
                float uu4[4];
#pragma unroll
                for (int rr = 0; rr < 4; ++rr) uu4[rr] = bf2f(yt[(tb * 16 + 4 * qd + rr) * S5_YS + g * 16 + l15]);
                LDS_WAIT(); __builtin_amdgcn_wave_barrier();
                s5_block16<true>(F, K, uw, sr, sim, scr);
                f32x4 acc = (f32x4){0.f, 0.f, 0.f, 0.f};
#pragma unroll
                for (int s2 = 0; s2 < 4; ++s2) { const bf16x8 af = *(const LAS bf16x8*)((LAS bf16*)scr + l15 * S5_SS + 32 * s2 + 8 * qd); acc = __builtin_amdgcn_mfma_f32_16x16x32_bf16(af, cfr[s2], acc, 0, 0, 0); }
#pragma unroll
                for (int rr = 0; rr < 4; ++rr) { const int t = tb * 16 + 4 * qd + rr;
                    yt[t * S5_YS + g * 16 + l15] = (bf16)f2bf(gelu_tanh(acc[rr] + dch * uu4[rr])); }
                LDS_WAIT(); __builtin_amdgcn_wave_barrier();
            }
        }
        __syncthreads();
        {
            const bf16* wt = (const bf16*)(F.ws + WS_WGLU) + (size_t)l * 65536;
            f32x4 acc[8][2];
#pragma unroll
            for (int tt = 0; tt < 8; ++tt) { acc[tt][0] = (f32x4){0.f, 0.f, 0.f, 0.f}; acc[tt][1] = (f32x4){0.f, 0.f, 0.f, 0.f}; }
#pragma unroll
            for (int s2 = 0; s2 < 8; ++s2) {
                const bf16x8 b0 = *(const bf16x8*)(wt + (size_t)(32 * F.wave + l15) * 256 + 32 * s2 + 8 * qd), b1 = *(const bf16x8*)(wt + (size_t)(32 * F.wave + 16 + l15) * 256 + 32 * s2 + 8 * qd);
#pragma unroll
                for (int tt = 0; tt < 8; ++tt) { const bf16x8 af = *(const LAS bf16x8*)(yt + (16 * tt + l15) * S5_YS + 32 * s2 + 8 * qd);
                    acc[tt][0] = __builtin_amdgcn_mfma_f32_16x16x32_bf16(af, b0, acc[tt][0], 0, 0, 0); acc[tt][1] = __builtin_amdgcn_mfma_f32_16x16x32_bf16(af, b1, acc[tt][1], 0, 0, 0); }
            }
            const int n0 = 32 * F.wave + l15;
            const float bg0 = F.in[I_BGLU][l * 256 + n0], bg1 = F.in[I_BGLU][l * 256 + n0 + 16], gn0 = F.in[I_S5N][l * 256 + n0], gn1 = F.in[I_S5N][l * 256 + n0 + 16];
#pragma unroll
            for (int tt = 0; tt < 8; ++tt)
#pragma unroll
                for (int rr = 0; rr < 4; ++rr) { const int t = 16 * tt + 4 * qd + rr;
                    const float o0 = bf2f(yt[t * S5_YS + n0]) * sigmoidf_(acc[tt][0][rr] + bg0), o1 = bf2f(yt[t * S5_YS + n0 + 16]) * sigmoidf_(acc[tt][1][rr] + bg1);
                    acc[tt][0][rr] = o0; acc[tt][1][rr] = o1;
                    float ss = o0 * o0 + o1 * o1; ss = row_sum16(ss);
                    if (l15 == 0) part[t * 8 + F.wave] = ss; }
            __syncthreads();
#pragma unroll
            for (int tt = 0; tt < 8; ++tt)
#pragma unroll
                for (int rr = 0; rr < 4; ++rr) { const int t = 16 * tt + 4 * qd + rr; const f32x4 p0 = *(const LAS f32x4*)(part + t * 8), p1 = *(const LAS f32x4*)(part + t * 8 + 4);
                    const float r = rsqf_((((p0.x + p0.y) + (p0.z + p0.w)) + ((p1.x + p1.y) + (p1.z + p1.w))) * (1.f / 256) + EPS);
                    const unsigned w = cvtpk(acc[tt][0][rr] * r * gn0, acc[tt][1][rr] * r * gn1); Y[(row0 + t) * D + n0] = (bf16)w; Y[(row0 + t) * D + n0 + 16] = (bf16)(w >> 16); }
        }
        __syncthreads();
    }
}


DI void moe_slot_phase(Frame& F) {
    LAS int* le = (LAS int*)F.lds;
    const int* TE = (const int*)(F.ws + WS_MISC + MS_TE); const int* CNT = (const int*)(F.ws + WS_MISC + MS_CNT);
    int* TS = (int*)(F.ws + WS_MISC + MS_TS); int* ST = (int*)(F.ws + WS_MISC + MS_ST); int* SEG = (int*)(F.ws + WS_MISC + MS_SEG);
    for (int w = F.vcu; w < 256; w += F.G) {
        LAS int* lcnt = le + 512;
        if (F.tid < 256) { const u32x4 a = *(const u32x4*)(CNT + F.tid * 8), b4 = *(const u32x4*)(CNT + F.tid * 8 + 4);
            *(LAS u32x4*)(lcnt + F.tid * 8) = a; *(LAS u32x4*)(lcnt + F.tid * 8 + 4) = b4; le[F.tid] = TE[(size_t)w * 256 + F.tid]; }
        __syncthreads();
        if (F.tid < 8) {
            int tot = 0, pre = 0;
#pragma unroll 16
            for (int ww = 0; ww < 256; ++ww) { const int cnt = lcnt[ww * 8 + F.tid]; tot += cnt; if (ww < w) pre += cnt; }
            le[256 + F.tid] = pre; le[264 + F.tid] = tot;
        }
        __syncthreads();
        if (F.tid == 0) { int s = 0; for (int e = 0; e < 8; ++e) { le[272 + e] = s; s += (le[264 + e] + 255) & ~255; } le[280] = s; }
        __syncthreads();
        if (F.tid < 256) {
            const int e = le[F.tid]; int rank = 0;
            for (int j = 0; j < F.tid; ++j) rank += (le[j] == e) ? 1 : 0;
            const int slot = le[272 + e] + le[256 + e] + rank;
            TS[(size_t)w * 256 + F.tid] = slot; ST[slot] = w * 128 + (F.tid >> 1);
        }
        if (w == 0) {
            if (F.tid < 9) SEG[F.tid] = le[272 + F.tid];
            if (F.tid == 9) SEG[9] = le[280] >> 8;
            for (int e = 0; e < 8; ++e) { const int s0 = le[272 + e] + le[264 + e], s1 = le[272 + e + 1]; for (int s = s0 + F.tid; s < s1; s += NTHR) ST[s] = 0; }
        }
        __syncthreads();
    }
}
DI void moe_combine_final_phase(Frame& F) {
    const float* TG = (const float*)(F.ws + WS_MISC + MS_TG); const int* TS = (const int*)(F.ws + WS_MISC + MS_TS);
    const bf16* Y0 = (const bf16*)(F.ws + WS_YB0); const bf16* Y1 = (const bf16*)(F.ws + WS_B);
    const float* gain = F.in[I_FINN];
    f32x4 gv[4];
#pragma unroll
    for (int j = 0; j < 4; ++j) gv[j] = *(const f32x4*)(gain + 4 * F.lane + 256 * j);
    for (int m0 = F.gw; m0 < T; m0 += 2 * F.NGW) {
        u32x2 hh[2][4], ya[2][4], yb[2][4]; float g0[2], g1[2];
#pragma unroll
        for (int r = 0; r < 2; ++r) { const int m = m0 + r * F.NGW;
            const u32x2 ss = *(const u32x2*)(TS + (size_t)m * 2); const f32x2 gg = *(const f32x2*)(TG + (size_t)m * 2); g0[r] = gg.x; g1[r] = gg.y;
            const int s0 = (int)ss.x, s1 = (int)ss.y;
            const bf16* y0 = (s0 < 32768) ? Y0 + (size_t)s0 * D : Y1 + (size_t)(s0 - 32768) * D;
            const bf16* y1 = (s1 < 32768) ? Y0 + (size_t)s1 * D : Y1 + (size_t)(s1 - 32768) * D;
            const u32x2* hr = (const u32x2*)((const bf16*)(F.ws + WS_H) + (size_t)m * D) + F.lane;
#pragma unroll
            for (int j = 0; j < 4; ++j) { hh[r][j] = hr[64 * j]; ya[r][j] = *((const u32x2*)y0 + F.lane + 64 * j); yb[r][j] = *((const u32x2*)y1 + F.lane + 64 * j); } }
#pragma unroll
        for (int r = 0; r < 2; ++r) { const int m = m0 + r * F.NGW;
            f32x4* xr = (f32x4*)(F.out + (size_t)m * D) + F.lane;
            f32x4 v[4]; float s = 0.f;
#pragma unroll
            for (int j = 0; j < 4; ++j) { const u32x2 h2 = hh[r][j], a = ya[r][j], bq = yb[r][j];
                v[j].x = bf2f(h2.x & 0xffffu) + (g0[r] * bf2f(a.x & 0xffffu) + g1[r] * bf2f(bq.x & 0xffffu)); v[j].y = bf2f(h2.x >> 16) + (g0[r] * bf2f(a.x >> 16) + g1[r] * bf2f(bq.x >> 16));
                v[j].z = bf2f(h2.y & 0xffffu) + (g0[r] * bf2f(a.y & 0xffffu) + g1[r] * bf2f(bq.y & 0xffffu)); v[j].w = bf2f(h2.y >> 16) + (g0[r] * bf2f(a.y >> 16) + g1[r] * bf2f(bq.y >> 16));
                s += (v[j].x * v[j].x + v[j].y * v[j].y) + (v[j].z * v[j].z + v[j].w * v[j].w); }
            const float rstd = rsqf_(wave_sum(s) * (1.f / D) + EPS);
#pragma unroll
            for (int j = 0; j < 4; ++j) xr[64 * j] = v[j] * rstd * gv[j]; }
    }
}

constexpr size_t HID_BYTES = (size_t)PASSP * 256 * DFE;
constexpr int NSTEPS = 25;
__global__ void __launch_bounds__(NTHR, 2) mk_fwd(Params prm) {
    extern __shared__ __attribute__((aligned(16))) unsigned char lds_raw[];
    Frame F;
    F.lds = (LAS unsigned char*)lds_raw; F.MISC = (volatile LAS unsigned*)(F.lds + MISC_OFF);
    F.tid = threadIdx.x; F.lane = F.tid & 63; F.wave = __builtin_amdgcn_readfirstlane(F.tid >> 6);
    F.G = gridDim.x; { const int bx = blockIdx.x; F.vcu = (F.G % 8 == 0) ? (bx % 8) * (F.G / 8) + bx / 8 : bx; }
    F.gw = F.vcu * NWAVES + F.wave; F.NGW = F.G * NWAVES;
    F.in = prm.in; F.out = prm.out; F.ws = prm.ws;
    for (int u = F.tid; u < (LDS_BYTES - LDSCTL_OFF) / 4; u += NTHR) ((LAS unsigned*)(F.lds + LDSCTL_OFF))[u] = 0u;
    __syncthreads();
    const int lo = prm.s_lo, hi = prm.s_hi;
    XcdBarrier bar; bar.bar = (unsigned*)(F.ws + WS_CTL) + CW_BAR; bar.x = 0; bar.st = nullptr;
    if (hi - lo > 1) bar = xcd_barrier_post((unsigned*)(F.ws + WS_CTL) + CW_BAR, F.MISC + 8);
#define ENTER() do { int _t = threadIdx.x, _b = blockIdx.x; asm volatile("" : "+v"(_t)); asm volatile("" : "+s"(_b)); F.tid = _t; F.lane = _t & 63; F.wave = __builtin_amdgcn_readfirstlane(_t >> 6); \
        F.bid = _b; F.vcu = (F.G % 8 == 0) ? (_b % 8) * (F.G / 8) + _b / 8 : _b; F.gw = F.vcu * NWAVES + F.wave; } while (0)
#define RUN(s) (lo <= (s) && (s) < hi)
#define SEAM(s) do { if (RUN(s) && RUN((s) + 1)) xcd_barrier(bar); } while (0)
    bf16* Hb = (bf16*)F.out; bf16* Rb = (bf16*)(F.ws + WS_H); bf16* Pb = (bf16*)(F.ws + WS_A); bf16* Yb = (bf16*)(F.ws + WS_B);
#define PHASE(k, ...) do { if constexpr (PH(k)) { for (int rp_ = 0; rp_ < REPS(k); ++rp_) { if (rp_) __syncthreads(); ENTER(); __VA_ARGS__; } } } while (0)
    if (RUN(0)) { PHASE(0, p0_prologue(F)); __syncthreads(); PHASE(1, norm_phase<0, false>(F, F.in[I_X], F.in[I_MIXN], 0)); }
    SEAM(0);
    for (int l = 0; l < 2; ++l) {
        const int sb = 1 + 9 * l;
        if (l > 0) { if (RUN(sb + 0)) PHASE(1, norm_phase<0, true>(F, Rb, F.in[I_MIXN] + l * D, l)); SEAM(sb + 0); }
        if (RUN(sb + 1)) PHASE(2, {
            pg8::DenseOrder S{T / 256, NP / 256, F.G, F.bid, D, (const bf16*)(F.ws + WS_WIN) + (size_t)l * NP * D};
            pg8::EpiStoreBf16 E{Pb, NP, 0, nullptr, 0};
            pg8::gemm_phase<pg8::EpiStoreBf16, pg8::DenseOrder, D, false, true, true>(F.lds, F.tid, Hb, nullptr, nullptr, S, E); });
        SEAM(sb + 1);
        if (RUN(sb + 2)) { PHASE(6, gdn_prep_phase(F, l)); __syncthreads(); PHASE(7, s5_pass1_phase(F, l)); }
        SEAM(sb + 2);
        if (RUN(sb + 3)) {
            PHASE(19, gdn_scan_phase(F, l));
            unsigned* qh = (unsigned*)(F.ws + WS_CTL) + 1024 + 64 * l;
            for (;;) {
                __syncthreads();
                if (F.tid == 0) F.MISC[16] = __hip_atomic_fetch_add(qh, 1u, __ATOMIC_RELAXED, __HIP_MEMORY_SCOPE_AGENT);
                __syncthreads();
                const int id = (int)F.MISC[16];
                if (id >= 768) break;
                if (id < 256) { PHASE(8, s5_pass3_phase(F, l, id, 1 << 20)); }
                else if (id < 512) { PHASE(4, gmlp_phase(F, l, id - 256, 1 << 20)); }
                else { PHASE(3, shortconv_phase(F, l, id - 512, 256)); }
            }
        }
        SEAM(sb + 3);
        if (RUN(sb + 4)) PHASE(20, gdn_finish_phase(F, l));
        SEAM(sb + 4);
        if (RUN(sb + 5)) PHASE(9, {
            pg8::DenseOrder S{T / 256, D / 256, F.G, F.bid, D, (const bf16*)(F.ws + WS_WOUT) + (size_t)l * D * D};
            if (l == 0) { pg8::EpiResBf16<true> E{F.in[I_X], Rb, D, 1.f};
                pg8::gemm_phase<pg8::EpiResBf16<true>, pg8::DenseOrder, D, false, true, true>(F.lds, F.tid, Yb, nullptr, nullptr, S, E); }
            else { pg8::EpiResBf16<false> E{Rb, Rb, D, 1.f};
                pg8::gemm_phase<pg8::EpiResBf16<false>, pg8::DenseOrder, D, false, true, true>(F.lds, F.tid, Yb, nullptr, nullptr, S, E); } });
        SEAM(sb + 5);
        if (l == 0) {
            if (RUN(sb + 6)) PHASE(10, norm_phase<1, true>(F, Rb, F.in[I_FFNN], 0));
            SEAM(sb + 6);
            if (RUN(sb + 7)) PHASE(11, {
                pg8::DenseOrder S{T / 256, 2 * DFF / 256, F.G, F.bid, D / 2, (const bf16*)(F.ws + WS_WGU)};
                pg8::EpiSwigluF8 E{(unsigned char*)Pb, DFF, 1.f / (F8_SA * F8_SW), F8_SH};
                pg8::gemm_phase<pg8::EpiSwigluF8, pg8::DenseOrder, D / 2, false, true, true, true>(F.lds, F.tid, Hb, nullptr, nullptr, S, E); });
            SEAM(sb + 7);
            if (RUN(sb + 8)) PHASE(12, {
                pg8::DenseOrder S{T / 256, D / 256, F.G, F.bid, DFF / 2, (const bf16*)(F.ws + WS_WDN)};
                pg8::EpiResBf16<false, true> E{Rb, Rb, D, 1.f / (F8_SH * F8_SWD)};
                pg8::gemm_phase<pg8::EpiResBf16<false, true>, pg8::DenseOrder, DFF / 2, false, true, true, true>(F.lds, F.tid, Pb, nullptr, nullptr, S, E); });
            SEAM(sb + 8);
        } else {
            if (RUN(sb + 6)) { PHASE(13, norm_phase<2, true>(F, Rb, F.in[I_FFNN] + D, 1)); __syncthreads(); PHASE(21, p0_moe_weights(F)); }
            SEAM(sb + 6);
            if (RUN(sb + 7)) PHASE(15, moe_slot_phase(F));
            SEAM(sb + 7);
            const int* SEG = (const int*)(F.ws + WS_MISC + MS_SEG);
            for (int k = 0; k < 6; ++k) {
                const int s0 = 18 + k;
                if (RUN(s0)) {
                    const int nMt = SEG[9] - 4 * PASSP;
                    if (k >= 1) {
                        const bool tail = (k == 1); const int ps = k - 2;
                        const int nM = tail ? nMt : PASSP, p0 = tail ? 4 * PASSP : ps * PASSP;
                        const bf16* Ah = tail ? (const bf16*)(F.ws + WS_HS) : (const bf16*)(F.ws + WS_A + (size_t)(ps & 1) * HID_BYTES);
                        if (nM > 0) PHASE(17, {
                            pg8::MoeOrder S{nM, D / 256, F.G, F.bid, DFE / 2, p0, (const bf16*)(F.ws + WS_MDN), (size_t)D * (DFE / 2), SEG, true, 0};
                            pg8::EpiStoreBf16S E{(bf16*)(F.ws + WS_YB0), D, p0, Yb, 32768, 1.f / (F8_SH * F8_SWD)};
                            pg8::gemm_phase<pg8::EpiStoreBf16S, pg8::MoeOrder, DFE / 2, false, true, true, true>(F.lds, F.tid, Ah, nullptr, nullptr, S, E); });
                    }
                    if (k <= 4) {
                        const bool tail = (k == 0); const int ps = k - 1;
                        const int nM = tail ? nMt : PASSP, p0 = tail ? 4 * PASSP : ps * PASSP;
                        const int nx = (k == 1 && nMt > 0) ? ((4 * nMt + 7) & ~7) : 0;
                        unsigned char* Hd = tail ? F.ws + WS_HS : F.ws + WS_A + (size_t)(ps & 1) * HID_BYTES;
                        if (k >= 1) __syncthreads();
                        if (nM > 0) PHASE(16, {
                            pg8::MoeOrder S{nM, 2 * DFE / 256, F.G, F.bid, D / 2, p0, (const bf16*)(F.ws + WS_MGU), (size_t)2 * DFE * (D / 2), SEG, false, nx};
                            pg8::EpiSwigluF8 E{Hd, DFE, 1.f / (F8_SA * F8_SW), F8_SH};
                            pg8::gemm_phase<pg8::EpiSwigluF8, pg8::MoeOrder, D / 2, true, true, true, true>(F.lds, F.tid, Hb, (const int*)(F.ws + WS_MISC + MS_ST), (LAS int*)(F.lds + RTAB_OFF), S, E); });
                    }
                }
                SEAM(s0);
            }
            if (RUN(24)) PHASE(18, moe_combine_final_phase(F));
        }
    }
#undef PHASE
#undef RUN
#undef SEAM
}

extern "C" void kernel_launch(void* const* d_in, const int* in_sizes, int n_in, void* d_out, int out_size, void* d_ws, size_t ws_size, hipStream_t stream) {
    static int grid = 0;
    if (grid == 0) {
        if (n_in != 35 || out_size != T * D || ws_size < WS_END) { fprintf(stderr, "kernel_launch: unexpected sizes (n_in %d out %d ws %zu)\n", n_in, out_size, ws_size); grid = -1; return; }
        int dev = 0, cus = 0;
        if (hipGetDevice(&dev) != hipSuccess || hipDeviceGetAttribute(&cus, hipDeviceAttributeMultiprocessorCount, dev) != hipSuccess) { grid = -1; return; }
        if (hipFuncSetAttribute((const void*)mk_fwd, hipFuncAttributeMaxDynamicSharedMemorySize, LDS_BYTES) != hipSuccess) { grid = -1; return; }
        (void)hipGetLastError();
        grid = cus;
    }
    if (grid < 0) return;
    (void)hipMemsetAsync((char*)d_ws + WS_CTL, 0, CTL_ZERO_BYTES, stream);
    Params p{};
    for (int i = 0; i < 35; ++i) p.in[i] = (const float*)d_in[i];
    p.out = (float*)d_out; p.ws = (unsigned char*)d_ws;
#if MK_ONE_LAUNCH
    p.s_lo = 0; p.s_hi = NSTEPS;
    hipLaunchKernelGGL(mk_fwd, dim3(grid), dim3(NTHR), LDS_BYTES, stream, p);
#else
    for (int s = 0; s < NSTEPS; ++s) { p.s_lo = s; p.s_hi = s + 1; hipLaunchKernelGGL(mk_fwd, dim3(grid), dim3(NTHR), LDS_BYTES, stream, p); }
#endif
}
```

```cpp
#include <hip/hip_runtime.h>
#include <cstdio>
#include <cstdint>

#ifndef PH_MASK
#define PH_MASK 0xFFFFFFFFu
#endif
#define PH(k) (((PH_MASK) >> (k)) & 1u)
#ifndef REP_MASK
#define REP_MASK 0u
#endif
#define REPS(k) ((((REP_MASK) >> (k)) & 1u) ? 2 : 1)
#ifndef MK_ONE_LAUNCH
#define MK_ONE_LAUNCH 1
#endif

#define DI __device__ __forceinline__
#define LAS __attribute__((address_space(3)))
#define GAS __attribute__((address_space(1)))
typedef unsigned short bf16;
typedef short bf16x8 __attribute__((ext_vector_type(8)));
typedef float f32x4 __attribute__((ext_vector_type(4)));
typedef float f32x2 __attribute__((ext_vector_type(2)));
typedef unsigned u32x4 __attribute__((ext_vector_type(4)));
typedef unsigned u32x2 __attribute__((ext_vector_type(2)));

constexpr int NB = 4, SEQ = 8192, D = 1024, T = NB * SEQ;
constexpr int NP = 2560;
constexpr int PC_S5 = 0, PC_GU = 256, PC_GV = 512, PC_Q = 768, PC_Z = 1536, PC_SCB = 1792, PC_SCC = 2048, PC_SCX = 2304;
constexpr int IN_COLS = 2568, DFF = 2816, NEXP = 8, DFE = 3584;
constexpr int S5CS = 128, S5NC = SEQ / S5CS;
constexpr float EPS = 1e-6f;
constexpr int NWAVES = 8, NTHR = 512;
constexpr int MAXPANEL = 264, PASSP = 200;

constexpr float F8_SA = 16.f, F8_SW = 256.f, F8_SH = 8.f, F8_SWD = 512.f;
constexpr size_t MiB = 1u << 20;
constexpr size_t WS_CTL = 0, CTL_ZERO_BYTES = 1 * MiB;
constexpr size_t WS_SMALL = 1 * MiB;
constexpr size_t WS_WIN = 4 * MiB, WS_WOUT = 14 * MiB, WS_WGU = 18 * MiB, WS_WDN = 29 * MiB, WS_WGLU = 35 * MiB, WS_MGU = 36 * MiB, WS_MDN = 176 * MiB;
constexpr size_t WS_H = 204 * MiB;
constexpr size_t WS_A = 268 * MiB;
constexpr size_t WS_YB0 = 92 * MiB;
constexpr size_t WS_B = 444 * MiB;
constexpr size_t WS_MISC = 512 * MiB;
constexpr size_t WS_END = 520 * MiB;
constexpr size_t WS_SGW = WS_SMALL + 1 * MiB;
constexpr size_t WS_HS = WS_WIN;
constexpr size_t WS_GOP = WS_MGU;
constexpr size_t WS_GO = WS_A + 160 * MiB;
constexpr int GOP_ISTRIDE = 50176;
constexpr int SM_AR = 0, SM_AI = 2048, SM_PR = 4096, SM_PI = 6144;
constexpr int SM_BBR = 8192, SM_BBI = SM_BBR + 32768;
constexpr int SM_WAB = SM_BBI + 32768;
constexpr int SM_WR = SM_WAB + 16384;
constexpr int SM_END = SM_WR + 8192;
constexpr size_t MS_AB = 0;
constexpr size_t MS_GB = 5 * MiB;
constexpr size_t MS_E = 1 * MiB;
constexpr size_t MS_TE = 3 * MiB;
constexpr size_t MS_TG = MS_TE + (size_t)T * 8;
constexpr size_t MS_TS = MS_TG + (size_t)T * 8;
constexpr size_t MS_ST = MS_TS + (size_t)T * 8;
constexpr size_t MS_CNT = MS_ST + (size_t)MAXPANEL * 256 * 4;
constexpr size_t MS_SEG = MS_CNT + 256 * 8 * 4;
constexpr int CW_BAR = 4096;

constexpr int RING_BYTES = 131072, LDSCTL_OFF = 155648, MISC_OFF = LDSCTL_OFF + 320, RTAB_OFF = RING_BYTES, LDS_BYTES = 159744;

DI float bf2f(unsigned b) { return __uint_as_float(b << 16); }
typedef __bf16 bf16x2_t __attribute__((ext_vector_type(2)));
DI unsigned cvtpk(float lo, float hi) { f32x2 v = {lo, hi}; bf16x2_t b = __builtin_convertvector(v, bf16x2_t); return __builtin_bit_cast(unsigned, b); }
DI unsigned f2bf(float f) { return cvtpk(f, f); }
DI unsigned pk2(float lo, float hi) { return cvtpk(lo, hi); }
template <int CTRL> DI float dpp_mov(float v) { return __builtin_bit_cast(float, __builtin_amdgcn_update_dpp(0, __builtin_bit_cast(int, v), CTRL, 0xf, 0xf, true)); }
DI float row_sum16(float v) {
    v += dpp_mov<0xB1>(v); v += dpp_mov<0x4E>(v); v += dpp_mov<0x141>(v); v += dpp_mov<0x140>(v); return v;
}
DI float wave_sum(float v) {
    v = row_sum16(v);
    asm volatile("s_nop 1\n\tv_add_f32_dpp %0, %0, %0 row_bcast:15 row_mask:0xa bank_mask:0xf\n\ts_nop 1\n\tv_add_f32_dpp %0, %0, %0 row_bcast:31 row_mask:0xc bank_mask:0xf\n\ts_nop 0" : "+v"(v));
    return __builtin_bit_cast(float, __builtin_amdgcn_readlane(__builtin_bit_cast(int, v), 63));
}
DI float rcpf_(float x) { return __builtin_amdgcn_rcpf(x); }
DI float rsqf_(float x) { return __builtin_amdgcn_rsqf(x); }
DI float sigmoidf_(float x) { return rcpf_(1.0f + __expf(-x)); }
DI float siluf_(float x) { return x * rcpf_(1.0f + __expf(-x)); }
DI float gelu_tanh(float x) { const float z = 0.7978845608028654f * (x + 0.044715f * x * x * x); const float e = __expf(2.0f * z); return 0.5f * x * (2.0f - 2.0f * rcpf_(e + 1.0f)); }
DI float softplusf_(float x) { return fmaxf(x, 0.f) + log1pf(__expf(-fabsf(x))); }
#define LDS_WAIT() asm volatile("s_waitcnt lgkmcnt(0)" ::: "memory")
#define VM_WAIT() asm volatile("s_waitcnt vmcnt(0)" ::: "memory")

#define XB_TMO      128
#define XB_XCNT(j)  (256  + 64 * (j))
#define XB_XSUB(j)  (1280 + 64 * (j))
#define XB_XGEN(j)  (2304 + 64 * (j))
#define XB_TOP      3328
#define XB_TOPGEN   3392
#define XCD_BAR_WORDS 3456
#define XB_SPIN_CAP (1u << 24)
DI unsigned xb_ld(unsigned* p)              { return __hip_atomic_load(p, __ATOMIC_RELAXED, __HIP_MEMORY_SCOPE_AGENT); }
DI unsigned xb_add(unsigned* p, unsigned v) { return __hip_atomic_fetch_add(p, v, __ATOMIC_RELAXED, __HIP_MEMORY_SCOPE_AGENT); }
DI unsigned xb_xcc_id() { return (unsigned)__builtin_amdgcn_s_getreg((3 << 11) | 20) & 0xFu; }
#define XB_SPIN(cond, bar) do { unsigned _sp = 0; while (cond) { __builtin_amdgcn_s_sleep(1); \
    if ((++_sp & 255u) == 0u) { if (xb_ld(&(bar)[XB_TMO])) break; if (_sp > XB_SPIN_CAP) { atomicAdd(&(bar)[XB_TMO], 1u); break; } } } } while (0)
struct XcdBarrier { unsigned* bar; unsigned x; volatile LAS unsigned* st; };
DI XcdBarrier xcd_barrier_post(unsigned* bar, volatile LAS unsigned* st) {
    XcdBarrier b; b.bar = bar; b.x = xb_xcc_id(); b.st = st;
    if (threadIdx.x == 0) (void)xb_add(&bar[XB_XCNT(b.x)], 1u);
    return b;
}
DI void xcd_barrier_complete(unsigned* bar, unsigned x, unsigned& nloc, unsigned& nx) {
    const unsigned G = gridDim.x * gridDim.y * gridDim.z;
    unsigned sum, cnt, mine, sp = 0u;
    for (;;) {
        sum = 0u; cnt = 0u; mine = 0u;
#pragma unroll
        for (unsigned j = 0; j < 16; ++j) { const unsigned c = xb_ld(&bar[XB_XCNT(j)]); sum += c; cnt += (c > 0u) ? 1u : 0u; mine = (j == x) ? c : mine; }
        if (sum == G) break;
        __builtin_amdgcn_s_sleep(1);
        if ((++sp & 255u) == 0u) { if (xb_ld(&bar[XB_TMO])) break; if (sp > XB_SPIN_CAP) { atomicAdd(&bar[XB_TMO], 1u); break; } }
    }
    nloc = mine > 0u ? mine : 1u; nx = cnt > 0u ? cnt : 1u;
}
DI void xcd_barrier(const XcdBarrier& b) {
    asm volatile("s_waitcnt vmcnt(0)" ::: "memory");
    __syncthreads();
    if (threadIdx.x == 0) {
        unsigned* bar = b.bar;
        __builtin_amdgcn_s_waitcnt(0);
        unsigned nloc = b.st[0], nx = b.st[1];
        if (nloc == 0u) { xcd_barrier_complete(bar, b.x, nloc, nx); b.st[0] = nloc; b.st[1] = nx; }
        const unsigned old = xb_add(&bar[XB_XSUB(b.x)], 1u);
        const unsigned gen = old / nloc;
        if (old + 1u == (gen + 1u) * nloc) {
            __builtin_amdgcn_fence(__ATOMIC_RELEASE, "agent");
            asm volatile("s_waitcnt vmcnt(0)" ::: "memory");
            const unsigned og = xb_add(&bar[XB_TOP], 1u);
            const unsigned tg = og / nx;
            if (og + 1u == (tg + 1u) * nx) xb_add(&bar[XB_TOPGEN], 1u);
            else XB_SPIN(xb_ld(&bar[XB_TOPGEN]) == tg, bar);
            __builtin_amdgcn_fence(__ATOMIC_ACQUIRE, "agent");
            xb_add(&bar[XB_XGEN(b.x)], 1u);
            asm volatile("s_waitcnt vmcnt(0)" ::: "memory");
        } else {
            XB_SPIN(xb_ld(&bar[XB_XGEN(b.x)]) == gen, bar);
            __builtin_amdgcn_fence(__ATOMIC_ACQUIRE, "agent");
            asm volatile("s_waitcnt vmcnt(0)" ::: "memory");
        }
    }
    __syncthreads();
}

namespace pg8 {
constexpr int BM = 256, BK = 64, HALF = 128, HTB = HALF * BK * 2, STAGE_BYTES = 8 * HTB, NXCD = 8, WGM = 4;
DI int lds_byte(int r, int c) { const int st = (r >> 4) * 2 + (c >> 5), rr = r & 15, cc = c & 31, ob = rr * 64 + cc * 2; return st * 1024 + (ob ^ (((ob >> 9) & 1) << 5)); }
DI void stage_rc(int b, int& R, int& C) { const int st = b / 1024, sb = b % 1024, swz = sb ^ (((sb >> 9) & 1) << 5); R = (st >> 1) * 16 + swz / 64; C = (st & 1) * 32 + (swz % 64) / 2; }
DI int perm32(int rho) { const int n = rho >> 4, i = rho & 15; return 8 * (i >> 2) + 4 * n + (i & 3); }
DI unsigned cvt_pk_bf16(float lo, float hi) { unsigned r; asm volatile("v_cvt_pk_bf16_f32 %0, %1, %2" : "=v"(r) : "v"(lo), "v"(hi)); return r; }

typedef int i32x8 __attribute__((ext_vector_type(8)));
typedef int i32x4v __attribute__((ext_vector_type(4)));
DI i32x8 pack8(bf16x8 lo, bf16x8 hi) { return __builtin_shufflevector(__builtin_bit_cast(i32x4v, lo), __builtin_bit_cast(i32x4v, hi), 0, 1, 2, 3, 4, 5, 6, 7); }
DI float clamp8(float x) { return __builtin_fminf(__builtin_fmaxf(x, -448.f), 448.f); }
DI unsigned pk_fp8x4(float a, float b, float c, float d) {
    int w = __builtin_amdgcn_cvt_pk_fp8_f32(clamp8(a), clamp8(b), 0, false); w = __builtin_amdgcn_cvt_pk_fp8_f32(clamp8(c), clamp8(d), w, true); return (unsigned)w; }
struct Unit { int pm, pn; int arow0; const char* B; };

DI bool tile_of(int i, int G, int c, int nM, int nN, int& pm, int& pn) {
    const int nwg = nM * nN; const long L = (long)i * G + c; if (L >= nwg) return false;
    int wgid = (int)L; { const int q = nwg / NXCD, r = nwg % NXCD, xcd = wgid % NXCD, off = wgid / NXCD; wgid = (xcd < r ? xcd * (q + 1) : r * (q + 1) + (xcd - r) * q) + off; }
    const int nig = WGM * nN, gid = wgid / nig, fm = gid * WGM, gsz = (nM - fm) < WGM ? (nM - fm) : WGM;
    pm = fm + ((wgid % nig) % gsz); pn = (wgid % nig) / gsz; return true;
}

template <class Epi, class Sched, int K, bool GATHER, bool ALIGN_EPI, bool SP2, bool FP8 = false>
DI void gemm_phase(LAS unsigned char* lds, const int tid, const bf16* Abase, const int* rowmap, LAS int* rtab, const Sched& S, const Epi& E) {
    const int wid = __builtin_amdgcn_readfirstlane(tid >> 6), lane = tid & 63, wr = wid >> 2, wc = wid & 3, fr = lane & 15, fq = lane >> 4;
    constexpr int nt = K / BK;
    unsigned voffB[2];
#pragma unroll
    for (int i = 0; i < 2; ++i) { int R, C; stage_rc(tid * 16 + i * 8192, R, C); const int Rb = Epi::PERM ? ((R & ~31) + perm32(R & 31)) : R; voffB[i] = (unsigned)(Rb * K + C) * 2u; }
    constexpr size_t kstep = (size_t)(BK * 2);
    constexpr size_t hstep = (size_t)HALF * K * 2;
    const unsigned ldsw = (unsigned)wid * 1024u;
    const int aoff = lds_byte(wr * 64 + fr, fq * 8), boff = lds_byte(wc * 32 + fr, fq * 8);
#define PG8_SA(b, h) (((b) * 2 + (h)) * HTB)
#define PG8_SB(b, h) ((4 + (b) * 2 + (h)) * HTB)
#define PG8_STAGE(bufoff, gbase, voff) do { _Pragma("unroll") for (int _i = 0; _i < 2; ++_i) \
        __builtin_amdgcn_global_load_lds((const unsigned*)((const char*)(gbase) + (voff)[_i]), (LAS unsigned*)(lds + (bufoff) + ldsw + _i * 8192), 16, 0, 0); } while (0)
#define PG8_LDA(dst, b, h) do { _Pragma("unroll") for (int m = 0; m < 4; ++m) { if constexpr (FP8) { dst##8[m] = __builtin_shufflevector(*(const LAS i32x4v*)(lds + PG8_SA(b, h) + aoff + m * 2048), *(const LAS i32x4v*)(lds + PG8_SA(b, h) + aoff + m * 2048 + 1024), 0, 1, 2, 3, 4, 5, 6, 7); } \
        else { _Pragma("unroll") for (int k = 0; k < 2; ++k) dst[m][k] = *(const LAS bf16x8*)(lds + PG8_SA(b, h) + aoff + m * 2048 + k * 1024); } } } while (0)
#define PG8_LDB(dst, b, h) do { _Pragma("unroll") for (int n = 0; n < 2; ++n) { if constexpr (FP8) { dst##8[n] = __builtin_shufflevector(*(const LAS i32x4v*)(lds + PG8_SB(b, h) + boff + n * 2048), *(const LAS i32x4v*)(lds + PG8_SB(b, h) + boff + n * 2048 + 1024), 0, 1, 2, 3, 4, 5, 6, 7); } \
        else { _Pragma("unroll") for (int k = 0; k < 2; ++k) dst[n][k] = *(const LAS bf16x8*)(lds + PG8_SB(b, h) + boff + n * 2048 + k * 1024); } } } while (0)
#define PG8_MMA(ai, bj, At, Bt) do { __builtin_amdgcn_s_setprio(1); _Pragma("unroll") for (int m = 0; m < 4; ++m) _Pragma("unroll") for (int n = 0; n < 2; ++n) { \
        if constexpr (FP8) { asm volatile("v_mfma_f32_16x16x128_f8f6f4 %0, %1, %2, %0" : "+v"(acc[ai][bj][m][n]) : "v"(Bt##8[n]), "v"(At##8[m])); } \
        else { _Pragma("unroll") for (int k = 0; k < 2; ++k) acc[ai][bj][m][n] = __builtin_amdgcn_mfma_f32_16x16x32_bf16(Bt[n][k], At[m][k], acc[ai][bj][m][n], 0, 0, 0); } } \
        __builtin_amdgcn_s_setprio(0); } while (0)
#define PG8_MMAZ(ai, bj, At, Bt) do { __builtin_amdgcn_s_setprio(1); _Pragma("unroll") for (int m = 0; m < 4; ++m) _Pragma("unroll") for (int n = 0; n < 2; ++n) { \
        if constexpr (FP8) { asm volatile("v_mfma_f32_16x16x128_f8f6f4 %0, %1, %2, 0" : "=&v"(acc[ai][bj][m][n]) : "v"(Bt##8[n]), "v"(At##8[m])); } \
        else { acc[ai][bj][m][n] = __builtin_amdgcn_mfma_f32_16x16x32_bf16(Bt[n][0], At[m][0], (f32x4){0.f, 0.f, 0.f, 0.f}, 0, 0, 0); acc[ai][bj][m][n] = __builtin_amdgcn_mfma_f32_16x16x32_bf16(Bt[n][1], At[m][1], acc[ai][bj][m][n], 0, 0, 0); } } \
        __builtin_amdgcn_s_setprio(0); } while (0)
#define PG8_WAIT_V(n) asm volatile("s_waitcnt vmcnt(" #n ")" ::: "memory")
#define PG8_WAIT_L(n) asm volatile("s_waitcnt lgkmcnt(" #n ")" ::: "memory")
#define PG8_BAR __builtin_amdgcn_s_barrier()
#define PG8_SCHED __builtin_amdgcn_sched_barrier(0)
#define PG8_AOFF(dst, arow0_, MODE) do { _Pragma("unroll") for (int _i = 0; _i < 2; ++_i) { int _R, _C; stage_rc(tid * 16 + _i * 8192, _R, _C); _Pragma("unroll") for (int _h = 0; _h < 2; ++_h) { \
        int _r = (arow0_) + _h * HALF + _R; if ((MODE) == 1) _r = rowmap[_r]; if ((MODE) == 2) _r = rtab[(arow0_) + _h * HALF + _R]; dst[_h][_i] = (unsigned)(_r * K + _C) * 2u; } } } while (0)
    Unit cur, nxt; int ui = 0;
    if (!S.next(0, cur)) return;
    f32x4 acc[2][2][4][2];
    if constexpr (!SP2) {
#pragma unroll
    for (int a = 0; a < 2; ++a)
#pragma unroll
        for (int b = 0; b < 2; ++b)
#pragma unroll
            for (int m = 0; m < 4; ++m)
#pragma unroll
                for (int n = 0; n < 2; ++n) acc[a][b][m][n] = (f32x4){0.f, 0.f, 0.f, 0.f};
    }
    bf16x8 At[4][2], B0[2][2], B1[2][2]; i32x8 At8[4], B08[2], B18[2];
    unsigned fA[2][2], c1[2];
    if constexpr (GATHER) {
        { Unit uu; for (int i = 0; i < 24 && S.next(i, uu); ++i) if (tid < 256) rtab[i * 256 + tid] = rowmap[uu.arow0 + tid]; }
        asm volatile("s_waitcnt vmcnt(0) lgkmcnt(0)" ::: "memory"); __builtin_amdgcn_s_barrier(); asm volatile("" ::: "memory");
        PG8_AOFF(fA, 0, 2);
    } else { PG8_AOFF(fA, cur.arow0, 0); }
    c1[0] = fA[1][0]; c1[1] = fA[1][1];
    const char* gA = (const char*)Abase;
    const char* cB = cur.B;
    if constexpr (SP2) {
        PG8_STAGE(PG8_SB(0, 0), cB, voffB); PG8_STAGE(PG8_SB(0, 1), cB + hstep, voffB); PG8_STAGE(PG8_SA(0, 0), gA, fA[0]); PG8_STAGE(PG8_SA(0, 1), gA, fA[1]);
        if (wr == 1) PG8_BAR;
        PG8_WAIT_V(2); PG8_BAR;
        PG8_STAGE(PG8_SB(1, 0), cB + kstep, voffB); PG8_STAGE(PG8_SA(1, 0), gA + kstep, fA[0]); PG8_STAGE(PG8_SB(1, 1), cB + hstep + kstep, voffB);
        PG8_WAIT_V(6); PG8_BAR;
    } else {
        PG8_STAGE(PG8_SB(0, 0), cB, voffB); PG8_STAGE(PG8_SA(0, 0), gA, fA[0]); PG8_STAGE(PG8_SB(0, 1), cB + hstep, voffB); PG8_STAGE(PG8_SA(0, 1), gA, fA[1]);
        if (wr == 1) PG8_BAR;
        PG8_WAIT_V(4); PG8_BAR;
        PG8_STAGE(PG8_SB(1, 0), cB + kstep, voffB); PG8_STAGE(PG8_SA(1, 0), gA + kstep, fA[0]); PG8_STAGE(PG8_SB(1, 1), cB + hstep + kstep, voffB);
        PG8_WAIT_V(6); PG8_BAR;
    }
    for (;;) {
        const bool has_next = S.next(ui + 1, nxt);
        const char* nB = has_next ? nxt.B : cB;
#pragma unroll 1
        for (int t = 0; t < nt; t += 2) {
            const bool last = (t == nt - 2);
            const char* a1 = gA + (size_t)(t + 1) * kstep;
            const char* a2 = last ? gA : gA + (size_t)(t + 2) * kstep; const char* b2 = last ? nB : cB + (size_t)(t + 2) * kstep;
            const char* a3 = a2 + kstep; const char* b3 = b2 + kstep;
            if (last && has_next) { if constexpr (GATHER) { PG8_AOFF(fA, (ui + 1) * 256, 2); } else { PG8_AOFF(fA, nxt.arow0, 0); } }
            if constexpr (SP2) {
            PG8_LDB(B0, 0, 0); PG8_LDB(B1, 0, 1); PG8_SCHED; PG8_LDA(At, 0, 0); PG8_STAGE(PG8_SA(1, 1), a1, c1);
            PG8_WAIT_V(8); PG8_WAIT_L(0); PG8_BAR; if (t == 0) { PG8_MMAZ(0, 0, At, B0); PG8_MMAZ(0, 1, At, B1); } else { PG8_MMA(0, 0, At, B0); PG8_MMA(0, 1, At, B1); } PG8_BAR; PG8_SCHED;
            PG8_LDA(At, 0, 1); PG8_STAGE(PG8_SB(0, 0), b2, voffB); PG8_STAGE(PG8_SB(0, 1), b2 + hstep, voffB); PG8_STAGE(PG8_SA(0, 0), a2, fA[0]);
            PG8_WAIT_V(8); PG8_WAIT_L(0); PG8_BAR; if (t == 0) { PG8_MMAZ(1, 0, At, B0); PG8_MMAZ(1, 1, At, B1); } else { PG8_MMA(1, 0, At, B0); PG8_MMA(1, 1, At, B1); } PG8_BAR; PG8_SCHED;
            PG8_LDB(B0, 1, 0); PG8_LDB(B1, 1, 1); PG8_SCHED; PG8_LDA(At, 1, 0); PG8_STAGE(PG8_SA(0, 1), a2, fA[1]);
            PG8_WAIT_V(8); PG8_WAIT_L(0); PG8_BAR; PG8_MMA(0, 0, At, B0); PG8_MMA(0, 1, At, B1); PG8_BAR; PG8_SCHED;
            PG8_LDA(At, 1, 1); PG8_STAGE(PG8_SB(1, 0), b3, voffB); PG8_STAGE(PG8_SB(1, 1), b3 + hstep, voffB); PG8_STAGE(PG8_SA(1, 0), a3, fA[0]);
            PG8_WAIT_V(8); PG8_WAIT_L(0); PG8_BAR; PG8_MMA(1, 0, At, B0); PG8_MMA(1, 1, At, B1); PG8_BAR; PG8_SCHED;
            } else {
            PG8_LDB(B0, 0, 0); PG8_SCHED; PG8_LDA(At, 0, 0); PG8_STAGE(PG8_SA(1, 1), a1, c1);
            PG8_WAIT_L(8); PG8_BAR; PG8_WAIT_L(0); PG8_MMA(0, 0, At, B0); PG8_BAR; PG8_SCHED;
            PG8_LDB(B1, 0, 1); PG8_STAGE(PG8_SB(0, 0), b2, voffB);
            PG8_BAR; PG8_WAIT_L(0); PG8_MMA(0, 1, At, B1); PG8_BAR;
            PG8_LDA(At, 0, 1); PG8_STAGE(PG8_SA(0, 0), a2, fA[0]);
            PG8_BAR; PG8_WAIT_L(0); PG8_MMA(1, 0, At, B0); PG8_BAR; PG8_SCHED;
            PG8_STAGE(PG8_SB(0, 1), b2 + hstep, voffB);
            PG8_WAIT_V(6); PG8_BAR; PG8_MMA(1, 1, At, B1); PG8_BAR;
            PG8_LDB(B0, 1, 0); PG8_SCHED; PG8_LDA(At, 1, 0); PG8_STAGE(PG8_SA(0, 1), a2, fA[1]);
            PG8_WAIT_L(8); PG8_BAR; PG8_WAIT_L(0); PG8_MMA(0, 0, At, B0); PG8_BAR; PG8_SCHED;
            PG8_LDB(B1, 1, 1); PG8_STAGE(PG8_SB(1, 0), b3, voffB);
            PG8_BAR; PG8_WAIT_L(0); PG8_MMA(0, 1, At, B1); PG8_BAR;
            PG8_LDA(At, 1, 1); PG8_STAGE(PG8_SA(1, 0), a3, fA[0]);
            PG8_BAR; PG8_WAIT_L(0); PG8_MMA(1, 0, At, B0); PG8_BAR; PG8_SCHED;
            PG8_STAGE(PG8_SB(1, 1), b3 + hstep, voffB);
            PG8_WAIT_V(6); PG8_BAR; PG8_MMA(1, 1, At, B1); PG8_BAR;
            }
        }
        if constexpr (ALIGN_EPI) { if (wr == 0) PG8_BAR; }
        if constexpr (FP8) { asm volatile("s_nop 15\n s_nop 15" ::: "memory"); }
        E(acc, cur, wr, wc, fr, fq);
        if (!has_next) break;
        if constexpr (!SP2) {
#pragma unroll
        for (int a = 0; a < 2; ++a)
#pragma unroll
            for (int b = 0; b < 2; ++b)
#pragma unroll
                for (int m = 0; m < 4; ++m)
#pragma unroll
                    for (int n = 0; n < 2; ++n) acc[a][b][m][n] = (f32x4){0.f, 0.f, 0.f, 0.f};
        }
        cur = nxt; cB = nB; ++ui; c1[0] = fA[1][0]; c1[1] = fA[1][1];
        if constexpr (ALIGN_EPI) { if (wr == 1) PG8_BAR; }
    }
    PG8_WAIT_V(0);
    if constexpr (!ALIGN_EPI) { if (wr == 0) PG8_BAR; }
    PG8_BAR;
#undef PG8_SA
#undef PG8_SB
#undef PG8_STAGE
#undef PG8_LDA
#undef PG8_LDB
#undef PG8_MMA
#undef PG8_MMAZ
#undef PG8_WAIT_V
#undef PG8_WAIT_L
#undef PG8_BAR
#undef PG8_SCHED
#undef PG8_AOFF
}

struct DenseOrder {
    int nM, nN, G, c, K; const bf16* Bt;
    DI bool next(int i, Unit& u) const { int pm, pn; if (!tile_of(i, G, c, nM, nN, pm, pn)) return false; u.pm = pm; u.pn = pn; u.arow0 = pm * BM; u.B = (const char*)(Bt + (size_t)pn * BM * K); return true; }
};
struct MoeOrder {
    int nM, nN, G, c, K, p0; const bf16* Bt; size_t estride; const int* seg; bool a_local;
    int nx, na;
    DI bool next(int i, Unit& u) const {
        int pm, pn;
        if (nx == 0 || i < na) { if (!tile_of(i, G, c, nM, nN, pm, pn)) return false; }
        else { if (c < nx) return false; if (!tile_of(0, 1, na * G + (i - na) * (G - nx) + (c - nx), nM, nN, pm, pn)) return false; }
        const int panel = p0 + pm, slot0 = panel * BM; int e = 0;
#pragma unroll
        for (int j = 1; j < 8; ++j) e += (slot0 >= seg[j]) ? 1 : 0;
        u.pm = pm; u.pn = pn; u.arow0 = a_local ? pm * BM : slot0; u.B = (const char*)(Bt + (size_t)e * estride + (size_t)pn * BM * K); return true;
    }
};

struct EpiStoreBf16 {
    static constexpr bool PERM = true;
    bf16* O; int ldc; int prow0;
    bf16* O2; int split_row;
    DI void operator()(const f32x4 (&acc)[2][2][4][2], const Unit& u, int wr, int wc, int fr, int fq) const {
        int rowt = (u.pm + prow0) * BM; bf16* base = O; if (O2 && rowt >= split_row) { base = O2; rowt -= split_row; }
        const int row0 = rowt + wr * 64 + fr, col0 = u.pn * BM + wc * 32 + 8 * fq;
#pragma unroll
        for (int ai = 0; ai < 2; ++ai)
#pragma unroll
            for (int m = 0; m < 4; ++m) { bf16* rowp = base + (size_t)(row0 + ai * HALF + m * 16) * ldc + col0;
#pragma unroll
                for (int bj = 0; bj < 2; ++bj) { const f32x4 v0 = acc[ai][bj][m][0], v1 = acc[ai][bj][m][1];
                    u32x4 w; w.x = cvt_pk_bf16(v0[0], v0[1]); w.y = cvt_pk_bf16(v0[2], v0[3]); w.z = cvt_pk_bf16(v1[0], v1[1]); w.w = cvt_pk_bf16(v1[2], v1[3]);
                    *(u32x4*)(rowp + bj * HALF) = w; } }
    }
};
template <bool RES_F32, bool SCALED = false> struct EpiResBf16 {
    static constexpr bool PERM = true;
    const void* res; bf16* hb; int ldc; float scale;
    DI void operator()(const f32x4 (&acc)[2][2][4][2], const Unit& u, int wr, int wc, int fr, int fq) const {
        const int row0 = u.pm * BM + wr * 64 + fr, col0 = u.pn * BM + wc * 32 + 8 * fq;
#pragma unroll
        for (int ai = 0; ai < 2; ++ai)
#pragma unroll
            for (int m = 0; m < 4; ++m) { const size_t off = (size_t)(row0 + ai * HALF + m * 16) * ldc + col0;
#pragma unroll
                for (int bj = 0; bj < 2; ++bj) { f32x4 r0, r1;
                    if constexpr (RES_F32) { const float* rp = (const float*)res + off + bj * HALF; r0 = *(const f32x4*)rp; r1 = *(const f32x4*)(rp + 4); }
                    else { const u32x4 w = *(const u32x4*)((const bf16*)res + off + bj * HALF);
                        r0 = (f32x4){__builtin_bit_cast(float, w.x << 16), __builtin_bit_cast(float, w.x & 0xffff0000u), __builtin_bit_cast(float, w.y << 16), __builtin_bit_cast(float, w.y & 0xffff0000u)};
                        r1 = (f32x4){__builtin_bit_cast(float, w.z << 16), __builtin_bit_cast(float, w.z & 0xffff0000u), __builtin_bit_cast(float, w.w << 16), __builtin_bit_cast(float, w.w & 0xffff0000u)}; }
                    const f32x4 v0 = SCALED ? r0 + acc[ai][bj][m][0] * scale : r0 + acc[ai][bj][m][0], v1 = SCALED ? r1 + acc[ai][bj][m][1] * scale : r1 + acc[ai][bj][m][1];
                    u32x4 o; o.x = cvt_pk_bf16(v0[0], v0[1]); o.y = cvt_pk_bf16(v0[2], v0[3]); o.z = cvt_pk_bf16(v1[0], v1[1]); o.w = cvt_pk_bf16(v1[2], v1[3]);
                    *(u32x4*)(hb + off + bj * HALF) = o; } }
    }
};
struct EpiStoreBf16S {
    static constexpr bool PERM = true;
    bf16* O; int ldc; int prow0; bf16* O2; int split_row; float scale;
    DI void operator()(const f32x4 (&acc)[2][2][4][2], const Unit& u, int wr, int wc, int fr, int fq) const {
        int rowt = (u.pm + prow0) * BM; bf16* base = O; if (O2 && rowt >= split_row) { base = O2; rowt -= split_row; }
        const int row0 = rowt + wr * 64 + fr, col0 = u.pn * BM + wc * 32 + 8 * fq;
#pragma unroll
        for (int ai = 0; ai < 2; ++ai)
#pragma unroll
            for (int m = 0; m < 4; ++m) { bf16* rowp = base + (size_t)(row0 + ai * HALF + m * 16) * ldc + col0;
#pragma unroll
                for (int bj = 0; bj < 2; ++bj) { const f32x4 v0 = acc[ai][bj][m][0] * scale, v1 = acc[ai][bj][m][1] * scale;
                    u32x4 w; w.x = cvt_pk_bf16(v0[0], v0[1]); w.y = cvt_pk_bf16(v0[2], v0[3]); w.z = cvt_pk_bf16(v1[0], v1[1]); w.w = cvt_pk_bf16(v1[2], v1[3]);
                    *(u32x4*)(rowp + bj * HALF) = w; } }
    }
};
struct EpiSwigluS {
    static constexpr bool PERM = true;
    bf16* Hd; int ldc; float ascale;
    DI void operator()(const f32x4 (&acc)[2][2][4][2], const Unit& u, int wr, int wc, int fr, int fq) const {
        const int row0 = u.pm * BM + wr * 64 + fr, col0 = u.pn * HALF + wc * 32 + 8 * fq;
#pragma unroll
        for (int ai = 0; ai < 2; ++ai)
#pragma unroll
            for (int m = 0; m < 4; ++m) { bf16* rowp = Hd + (size_t)(row0 + ai * HALF + m * 16) * ldc + col0;
                float h[8];
#pragma unroll
                for (int n = 0; n < 2; ++n)
#pragma unroll
                    for (int e = 0; e < 4; ++e) { const float g = acc[ai][0][m][n][e] * ascale, up = acc[ai][1][m][n][e] * ascale; h[n * 4 + e] = g * __builtin_amdgcn_rcpf(1.0f + __expf(-g)) * up; }
                u32x4 w; w.x = cvt_pk_bf16(h[0], h[1]); w.y = cvt_pk_bf16(h[2], h[3]); w.z = cvt_pk_bf16(h[4], h[5]); w.w = cvt_pk_bf16(h[6], h[7]);
                *(u32x4*)rowp = w; }
    }
};
struct EpiSwigluF8 {
    static constexpr bool PERM = true;
    unsigned char* Hd; int ldc; float ascale, hscale;
    DI void operator()(const f32x4 (&acc)[2][2][4][2], const Unit& u, int wr, int wc, int fr, int fq) const {
        const int row0 = u.pm * BM + wr * 64 + fr, col0 = u.pn * HALF + wc * 32 + 8 * fq;
        const float c1 = -1.4426950408889634f * ascale, k2 = 1.0f / (ascale * ascale * hscale);
#pragma unroll
        for (int ai = 0; ai < 2; ++ai)
#pragma unroll
            for (int m = 0; m < 4; ++m) { unsigned char* rowp = Hd + (size_t)(row0 + ai * HALF + m * 16) * ldc + col0;
                float h[8];
#pragma unroll
                for (int n = 0; n < 2; ++n)
#pragma unroll
                    for (int e = 0; e < 4; ++e) { const float ag = acc[ai][0][m][n][e], au = acc[ai][1][m][n][e];
                        h[n * 4 + e] = (ag * au) * __builtin_amdgcn_rcpf(__builtin_fmaf(__builtin_amdgcn_exp2f(ag * c1), k2, k2)); }
                u32x2 w; w.x = pk_fp8x4(h[0], h[1], h[2], h[3]); w.y = pk_fp8x4(h[4], h[5], h[6], h[7]);
                *(u32x2*)rowp = w; }
    }
};
struct EpiSwiglu {
    static constexpr bool PERM = true;
    bf16* Hd; int ldc;
    DI void operator()(const f32x4 (&acc)[2][2][4][2], const Unit& u, int wr, int wc, int fr, int fq) const {
        const int row0 = u.pm * BM + wr * 64 + fr, col0 = u.pn * HALF + wc * 32 + 8 * fq;
#pragma unroll
        for (int ai = 0; ai < 2; ++ai)
#pragma unroll
            for (int m = 0; m < 4; ++m) { bf16* rowp = Hd + (size_t)(row0 + ai * HALF + m * 16) * ldc + col0;
                float h[8];
#pragma unroll
                for (int n = 0; n < 2; ++n)
#pragma unroll
                    for (int e = 0; e < 4; ++e) { const float g = acc[ai][0][m][n][e], up = acc[ai][1][m][n][e]; h[n * 4 + e] = g * __builtin_amdgcn_rcpf(1.0f + __expf(-g)) * up; }
                u32x4 w; w.x = cvt_pk_bf16(h[0], h[1]); w.y = cvt_pk_bf16(h[2], h[3]); w.z = cvt_pk_bf16(h[4], h[5]); w.w = cvt_pk_bf16(h[6], h[7]);
                *(u32x4*)rowp = w; }
    }
};
}
using pg8::pk_fp8x4;

struct Params { const float* in[35]; float* out; unsigned char* ws; int s_lo, s_hi; };
struct Frame {
    LAS unsigned char* lds; volatile LAS unsigned* MISC;
    int tid, lane, wave, vcu, G, gw, NGW, bid;
    const float* const* in; float* out; unsigned char* ws;
};
enum { I_X = 0, I_MIXN, I_WIN, I_LRE, I_LIM, I_LSTEP, I_BRE, I_BIM, I_CRE, I_CIM, I_S5D, I_WGLU, I_BGLU, I_S5N, I_LNG, I_LNB, I_SGUW, I_SGUB, I_GMN,
       I_GCONV, I_ALOG, I_DTB, I_GDNN, I_SCCONV, I_SCN, I_WOUT, I_FFNN, I_FG, I_FU, I_FD, I_ROUT, I_MG, I_MU, I_MD, I_FINN };

constexpr int TR_LDS = 64 * 65 * 4;
DI void tr_block(const float* W, int ld, int scol0, bf16* WT, int K, int drow0, int k0, LAS float* scr, int lane, float f8scale = 0.f) {
    f32x4 v[16];
    const float* src = W + (size_t)(k0 + (lane >> 4)) * ld + scol0 + (lane & 15) * 4;
#pragma unroll
    for (int i = 0; i < 16; ++i) v[i] = *(const f32x4*)(src + (size_t)(4 * i) * ld);
#pragma unroll
    for (int i = 0; i < 16; ++i) { LAS float* d = scr + (4 * i + (lane >> 4)) * 65 + (lane & 15) * 4; d[0] = v[i].x; d[1] = v[i].y; d[2] = v[i].z; d[3] = v[i].w; }
    LDS_WAIT(); asm volatile("" ::: "memory");
    const int c = lane & 7;
#pragma unroll
    for (int j = 0; j < 8; ++j) { const int n = (lane >> 3) + 8 * j; const LAS float* sp = scr + (8 * c) * 65 + n;
        if (f8scale != 0.f) { u32x2 o; o.x = pk_fp8x4(sp[0 * 65] * f8scale, sp[1 * 65] * f8scale, sp[2 * 65] * f8scale, sp[3 * 65] * f8scale);
            o.y = pk_fp8x4(sp[4 * 65] * f8scale, sp[5 * 65] * f8scale, sp[6 * 65] * f8scale, sp[7 * 65] * f8scale);
            *(u32x2*)((unsigned char*)WT + (size_t)(drow0 + n) * K + k0 + 8 * c) = o; }
        else { u32x4 o; o.x = cvtpk(sp[0 * 65], sp[1 * 65]); o.y = cvtpk(sp[2 * 65], sp[3 * 65]); o.z = cvtpk(sp[4 * 65], sp[5 * 65]); o.w = cvtpk(sp[6 * 65], sp[7 * 65]);
            *(u32x4*)(WT + (size_t)(drow0 + n) * K + k0 + 8 * c) = o; } }
    LDS_WAIT(); asm volatile("" ::: "memory");
}
DI void tr_item(int item, const float* W0, const float* W1, int ld, int K, int Nd, bf16* WT, int mode, LAS float* scr, int lane, float f8scale = 0.f) {
    const int nnb = Nd / 64, kb = item / nnb, nb = item % nnb, k0 = kb * 64, r0 = nb * 64;
    const float* W = W0; int scol0 = r0;
    if (mode == 1) scol0 = (r0 < 1792) ? r0 : r0 + 8;
    if (mode == 2) { const int tile = r0 >> 8, w = r0 & 255; W = (w < 128) ? W0 : W1; scol0 = tile * 128 + (w & 127); }
    tr_block(W, ld, scol0, WT, K, r0, k0, scr, lane, f8scale);
}
DI void sincos_pi(float r, float& s, float& c) {
    float sg = 1.f;
    if (r > 1.5707963267948966f) { r = 3.14159265358979f - r; sg = -1.f; } else if (r < -1.5707963267948966f) { r = -3.14159265358979f - r; sg = -1.f; }
    const float x2 = r * r;
    s = r * (1.f + x2 * (-1.f / 6 + x2 * (1.f / 120 + x2 * (-1.f / 5040 + x2 * (1.f / 362880 + x2 * (-1.f / 39916800 + x2 * (1.f / 6227020800.f)))))));
    c = sg * (1.f + x2 * (-0.5f + x2 * (1.f / 24 + x2 * (-1.f / 720 + x2 * (1.f / 40320 + x2 * (-1.f / 3628800 + x2 * (1.f / 479001600 + x2 * (-1.f / 87178291200.f))))))));
}
DI void p0_prologue(Frame& F) {
    LAS float* scr = (LAS float*)(F.lds + F.wave * TR_LDS);
    float* SM = (float*)(F.ws + WS_SMALL);
    constexpr int N_IN = 16 * 40, N_OUT = 16 * 16, N_GU = 16 * 88, N_DN = 44 * 16, N_GLU = 4 * 4;
    constexpr int NITEMS = 2 * N_IN + 2 * N_OUT + N_GU + N_DN + 2 * N_GLU;
    for (int it = F.gw; it < NITEMS; it += F.NGW) {
        int r = it;
        if (r < 2 * N_IN) { const int l = r / N_IN; tr_item(r % N_IN, F.in[I_WIN] + (size_t)l * D * IN_COLS, nullptr, IN_COLS, D, NP, (bf16*)(F.ws + WS_WIN) + (size_t)l * NP * D, 1, scr, F.lane); continue; } r -= 2 * N_IN;
        if (r < 2 * N_OUT) { const int l = r / N_OUT; tr_item(r % N_OUT, F.in[I_WOUT] + (size_t)l * D * D, nullptr, D, D, D, (bf16*)(F.ws + WS_WOUT) + (size_t)l * D * D, 0, scr, F.lane); continue; } r -= 2 * N_OUT;
        if (r < N_GU) { tr_item(r, F.in[I_FG], F.in[I_FU], DFF, D, 2 * DFF, (bf16*)(F.ws + WS_WGU), 2, scr, F.lane, F8_SW); continue; } r -= N_GU;
        if (r < N_DN) { tr_item(r, F.in[I_FD], nullptr, D, DFF, D, (bf16*)(F.ws + WS_WDN), 0, scr, F.lane, F8_SWD); continue; } r -= N_DN;
        { const int l = r / N_GLU; tr_item(r % N_GLU, F.in[I_WGLU] + (size_t)l * 65536, nullptr, 256, 256, 256, (bf16*)(F.ws + WS_WGLU) + (size_t)l * 65536, 0, scr, F.lane); }
    }
    for (int jb = F.vcu; jb < 256; jb += F.G) if (F.tid < 128) {
        const int j = jb * 128 + F.tid, i = j >> 4, q = j & 15;
        const int lg = i >> 6;
        const float dt = __expf(F.in[I_LSTEP][lg]);
        const float lr = F.in[I_LRE][i], li = F.in[I_LIM][i];
        const float br = F.in[I_BRE][(size_t)i * 16 + q], bi = F.in[I_BIM][(size_t)i * 16 + q];
        const float mag = __expf(lr * dt); const float ang = li * dt;
        const float rr = ang - 6.283185307179586f * rintf(ang * 0.15915494309189535f);
        float sn, cs; sincos_pi(rr, sn, cs);
        const float ar = mag * cs, ai = mag * sn;
        const float den = lr * lr + li * li;
        const float fr = ((ar - 1.f) * lr + ai * li) / den, fi = (ai * lr - (ar - 1.f) * li) / den;
        SM[SM_BBR + (size_t)i * 16 + q] = fr * br - fi * bi; SM[SM_BBI + (size_t)i * 16 + q] = fr * bi + fi * br;
        if (q == 0) {
            float pr = ar, pi = ai;
#pragma unroll
            for (int k = 0; k < 7; ++k) { const float t = pr * pr - pi * pi; pi = 2.f * pr * pi; pr = t; }
            SM[SM_AR + i] = ar; SM[SM_AI + i] = ai; SM[SM_PR + i] = pr; SM[SM_PI + i] = pi;
        }
    }
    const int gt = F.vcu * NTHR + F.tid, NGT = F.G * NTHR;
    { bf16* SGW = (bf16*)(F.ws + WS_SGW);
      for (int i = gt; i < 2 * 4 * 128 * 128; i += NGT) { const int tt = (i >> 7) & 127, ss = i & 127; SGW[i] = (bf16)f2bf(ss <= tt ? F.in[I_SGUW][i] : 0.f); } }
}

DI void p0_moe_weights(Frame& F) {
    LAS float* scr = (LAS float*)(F.lds + F.wave * TR_LDS);
    constexpr int N_MGU = 16 * 112, N_MDN = 56 * 16;
    for (int it = F.gw; it < 8 * N_MGU + 8 * N_MDN; it += F.NGW) {
        int r = it;
        if (r < 8 * N_MGU) { const int e = r / N_MGU; tr_item(r % N_MGU, F.in[I_MG] + (size_t)e * D * DFE, F.in[I_MU] + (size_t)e * D * DFE, DFE, D, 2 * DFE, (bf16*)(F.ws + WS_MGU + (size_t)e * 2 * DFE * D), 2, scr, F.lane, F8_SW); continue; } r -= 8 * N_MGU;
        { const int e = r / N_MDN; tr_item(r % N_MDN, F.in[I_MD] + (size_t)e * DFE * D, nullptr, D, DFE, D, (bf16*)(F.ws + WS_MDN + (size_t)e * D * DFE), 0, scr, F.lane, F8_SWD); }
    }
}
template <bool XBF> struct RowRaw;
template <> struct RowRaw<false> { f32x4 r[4];
    DI void load(const void* x, size_t row, int lane) { const f32x4* p = (const f32x4*)((const float*)x + row * D) + lane;
#pragma unroll
        for (int j = 0; j < 4; ++j) r[j] = p[64 * j]; }
    DI f32x4 get(int j) const { return r[j]; } };
template <> struct RowRaw<true> { u32x2 r[4];
    DI void load(const void* x, size_t row, int lane) { const u32x2* p = (const u32x2*)((const bf16*)x + row * D) + lane;
#pragma unroll
        for (int j = 0; j < 4; ++j) r[j] = p[64 * j]; }
    DI f32x4 get(int j) const { return (f32x4){bf2f(r[j].x & 0xffffu), bf2f(r[j].x >> 16), bf2f(r[j].y & 0xffffu), bf2f(r[j].y >> 16)}; } };
template <int MODE, bool XBF> DI void norm_phase(Frame& F, const void* x, const float* gain, int l) {
    bf16* H = (bf16*)F.out;
    LAS int* lc = (LAS int*)F.lds;
    f32x4 gv[4];
#pragma unroll
    for (int j = 0; j < 4; ++j) gv[j] = *(const f32x4*)(gain + 4 * F.lane + 256 * j);
    f32x2 wp[4][4][4];
    if (MODE == 0 || MODE == 2) {
#pragma unroll
        for (int j = 0; j < 4; ++j)
#pragma unroll
            for (int c = 0; c < 4; ++c) { const int d = 4 * F.lane + 256 * j + c;
                const float* src = (MODE == 0) ? F.in[I_WIN] + ((size_t)l * D + d) * IN_COLS + 1792 : F.in[I_ROUT] + (size_t)d * 8;
                const f32x4 w0 = *(const f32x4*)src, w1 = *(const f32x4*)(src + 4); const float g = gv[j][c];
                wp[0][j][c] = (f32x2){w0.x * g, w0.y * g}; wp[1][j][c] = (f32x2){w0.z * g, w0.w * g}; wp[2][j][c] = (f32x2){w1.x * g, w1.y * g}; wp[3][j][c] = (f32x2){w1.z * g, w1.w * g}; }
    }
    for (int blk = F.vcu; blk < T / 128; blk += F.G) {
        if (MODE == 2) { if (F.tid < 8) lc[F.tid] = 0; __syncthreads(); }
        constexpr int NPF = XBF ? 4 : 2;
        RowRaw<XBF> vn[NPF];
#pragma unroll
        for (int k = 0; k < NPF; ++k) vn[k].load(x, (size_t)(blk * 128 + F.wave + 8 * k), F.lane);
#pragma unroll NPF
        for (int k = 0; k < 16; ++k) {
            const int m = blk * 128 + F.wave + 8 * k;
            f32x4 v[4]; float s = 0.f;
#pragma unroll
            for (int j = 0; j < 4; ++j) v[j] = vn[k % NPF].get(j);
            vn[k % NPF].load(x, (size_t)(m + (k < 16 - NPF ? 8 * NPF : 0)), F.lane);
#pragma unroll
            for (int j = 0; j < 4; ++j) s += (v[j].x * v[j].x + v[j].y * v[j].y) + (v[j].z * v[j].z + v[j].w * v[j].w);
            const float rstd = rsqf_(wave_sum(s) * (1.f / D) + EPS);
            if (MODE == 1 || MODE == 2) {
                unsigned* o4 = (unsigned*)((unsigned char*)H + (size_t)m * D) + F.lane;
#pragma unroll
                for (int j = 0; j < 4; ++j) { const f32x4 h = v[j] * (rstd * F8_SA) * gv[j]; o4[64 * j] = pk_fp8x4(h.x, h.y, h.z, h.w); }
            } else {
            unsigned long long* o8 = (unsigned long long*)(H + (size_t)m * D) + F.lane;
#pragma unroll
            for (int j = 0; j < 4; ++j) { const f32x4 h = v[j] * rstd * gv[j]; o8[64 * j] = (unsigned long long)cvtpk(h.x, h.y) | ((unsigned long long)cvtpk(h.z, h.w) << 32); }
            }
            if (MODE == 0 || MODE == 2) {
                float d8[8];
                f32x2 a2[4] = {(f32x2){0.f, 0.f}, (f32x2){0.f, 0.f}, (f32x2){0.f, 0.f}, (f32x2){0.f, 0.f}};
#pragma unroll
                for (int j = 0; j < 4; ++j)
#pragma unroll
                    for (int c = 0; c < 4; ++c)
#pragma unroll
                        for (int ep = 0; ep < 4; ++ep) a2[ep] += (f32x2){v[j][c], v[j][c]} * wp[ep][j][c];
#pragma unroll
                for (int ep = 0; ep < 4; ++ep) { d8[2 * ep] = wave_sum(a2[ep].x) * rstd; d8[2 * ep + 1] = wave_sum(a2[ep].y) * rstd; }
                if (MODE == 0) {
                    if (F.lane == 0) { float* ab = (float*)(F.ws + WS_MISC + MS_AB) + (size_t)m * 8; *(f32x4*)ab = (f32x4){d8[0], d8[1], d8[2], d8[3]}; *(f32x4*)(ab + 4) = (f32x4){d8[4], d8[5], d8[6], d8[7]}; }
                } else {
                    int e0 = 0; float l0 = d8[0];
#pragma unroll
                    for (int e = 1; e < 8; ++e) if (d8[e] > l0) { l0 = d8[e]; e0 = e; }
                    int e1 = -1; float l1 = -3.0e38f;
#pragma unroll
                    for (int e = 0; e < 8; ++e) if (e != e0 && d8[e] > l1) { l1 = d8[e]; e1 = e; }
                    const float g0 = 1.0f / (1.0f + __expf(l1 - l0));
                    if (F.lane == 0) { int* te = (int*)(F.ws + WS_MISC + MS_TE) + (size_t)m * 2; te[0] = e0; te[1] = e1; float* tg = (float*)(F.ws + WS_MISC + MS_TG) + (size_t)m * 2; tg[0] = g0; tg[1] = 1.0f - g0;
                        __hip_atomic_fetch_add(&lc[e0], 1, __ATOMIC_RELAXED, __HIP_MEMORY_SCOPE_WORKGROUP); __hip_atomic_fetch_add(&lc[e1], 1, __ATOMIC_RELAXED, __HIP_MEMORY_SCOPE_WORKGROUP); }
                }
            }
        }
        if (MODE == 2) { __syncthreads(); if (F.tid < 8) ((int*)(F.ws + WS_MISC + MS_CNT))[blk * 8 + F.tid] = lc[F.tid]; __syncthreads(); }
    }
}

DI void shortconv_phase(Frame& F, int l, int wg0, int nwg) {
    const bf16* P = (const bf16*)(F.ws + WS_A); bf16* Y = (bf16*)(F.ws + WS_B);
    const float* cw = F.in[I_SCCONV] + l * 768; const float* gn = F.in[I_SCN] + l * 256;
    const int c = F.lane * 4;
    float w[3][4], g4[4];
#pragma unroll
    for (int j = 0; j < 3; ++j)
#pragma unroll
        for (int e = 0; e < 4; ++e) w[j][e] = cw[j * 256 + c + e];
#pragma unroll
    for (int e = 0; e < 4; ++e) g4[e] = gn[c + e];
    for (int half = 0; half < 2; ++half) {
        const int r0 = wg0 * 128 + F.wave * 16 + half * 8, tl = r0 & (SEQ - 1);
        u32x2 cc[10], xx[10], bb[8];
#pragma unroll
        for (int i = 0; i < 10; ++i) { const int m = (tl - 2 + i >= 0) ? r0 - 2 + i : r0;
            cc[i] = *(const u32x2*)(P + (size_t)m * NP + PC_SCC + c); xx[i] = *(const u32x2*)(P + (size_t)m * NP + PC_SCX + c); }
#pragma unroll
        for (int i = 0; i < 8; ++i) bb[i] = *(const u32x2*)(P + (size_t)(r0 + i) * NP + PC_SCB + c);
        float cx[10][4];
#pragma unroll
        for (int i = 0; i < 10; ++i) { const float z = (tl - 2 + i >= 0) ? 1.f : 0.f;
            cx[i][0] = z * bf2f(cc[i].x & 0xffffu) * bf2f(xx[i].x & 0xffffu); cx[i][1] = z * bf2f(cc[i].x >> 16) * bf2f(xx[i].x >> 16);
            cx[i][2] = z * bf2f(cc[i].y & 0xffffu) * bf2f(xx[i].y & 0xffffu); cx[i][3] = z * bf2f(cc[i].y >> 16) * bf2f(xx[i].y >> 16); }
#pragma unroll
        for (int i = 0; i < 8; ++i) {
            const int m = r0 + i;
            float acc[4];
#pragma unroll
            for (int e = 0; e < 4; ++e) acc[e] = w[0][e] * cx[i][e] + w[1][e] * cx[i + 1][e] + w[2][e] * cx[i + 2][e];
            float o[4] = {acc[0] * bf2f(bb[i].x & 0xffffu), acc[1] * bf2f(bb[i].x >> 16), acc[2] * bf2f(bb[i].y & 0xffffu), acc[3] * bf2f(bb[i].y >> 16)};
            const float ss = wave_sum((o[0] * o[0] + o[1] * o[1]) + (o[2] * o[2] + o[3] * o[3]));
            const float r = rsqf_(ss * (1.f / 256) + EPS);
            u32x2 ov; ov.x = pk2(o[0] * r * g4[0], o[1] * r * g4[1]); ov.y = pk2(o[2] * r * g4[2], o[3] * r * g4[3]);
            *(u32x2*)(Y + (size_t)m * D + 768 + c) = ov;
        }
    }
}
constexpr int GM_SV = 136;
DI void gmlp_phase(Frame& F, int l, int wg0, int nwg) {
    const bf16* P = (const bf16*)(F.ws + WS_A); bf16* Y = (bf16*)(F.ws + WS_B);
    LAS bf16* vT = (LAS bf16*)F.lds;
    LAS float* part = (LAS float*)(F.lds + 69632);
    const float* lng = F.in[I_LNG] + l * 256; const float* lnb = F.in[I_LNB] + l * 256; const float* gn = F.in[I_GMN] + l * 256;
    const bf16* wb = (const bf16*)(F.ws + WS_SGW) + (size_t)l * 4 * 128 * 128; const float* sb = F.in[I_SGUB] + l * 512;
    const int l15 = F.lane & 15, qd = F.lane >> 4, h = F.wave >> 1, half = F.wave & 1;
    for (int ch = wg0; ch < T / 128; ch += nwg) {
        const int t0 = ch * 128;
        { const int c = F.lane * 4;
          const f32x4 g4 = *(const f32x4*)(lng + c), b4 = *(const f32x4*)(lnb + c);
          u32x2 pv16[16];
#pragma unroll
          for (int k = 0; k < 16; ++k) pv16[k] = *(const u32x2*)(P + (size_t)(t0 + F.wave + NWAVES * k) * NP + PC_GV + c);
#pragma unroll
          for (int k = 0; k < 16; ++k) { const int s = F.wave + NWAVES * k;
            const u32x2 pv = pv16[k];
            float z[4] = {gelu_tanh(bf2f(pv.x & 0xffffu)), gelu_tanh(bf2f(pv.x >> 16)), gelu_tanh(bf2f(pv.y & 0xffffu)), gelu_tanh(bf2f(pv.y >> 16))};
            const float mean = wave_sum((z[0] + z[1]) + (z[2] + z[3])) * (1.f / 256);
            float q2 = 0.f;
#pragma unroll
            for (int e = 0; e < 4; ++e) { z[e] -= mean; q2 += z[e] * z[e]; }
            const float r = rsqf_(wave_sum(q2) * (1.f / 256) + EPS);
#pragma unroll
            for (int e = 0; e < 4; ++e) vT[(c + e) * GM_SV + s] = (bf16)f2bf(z[e] * r * g4[e] + b4[e]);
          } }
        unsigned short ur[4][4][4]; float bs[4][4];
#pragma unroll
        for (int i = 0; i < 4; ++i)
#pragma unroll
            for (int rr = 0; rr < 4; ++rr) { const int t = 16 * (half + 2 * i) + 4 * qd + rr; bs[i][rr] = sb[h * 128 + t];
#pragma unroll
                for (int nt = 0; nt < 4; ++nt) ur[i][rr][nt] = P[(size_t)(t0 + t) * NP + PC_GU + 64 * h + 16 * nt + l15]; }
        __syncthreads();
        f32x4 acc[4][4];
#pragma unroll
        for (int i = 0; i < 4; ++i)
#pragma unroll
            for (int nt = 0; nt < 4; ++nt) acc[i][nt] = (f32x4){0.f, 0.f, 0.f, 0.f};
#pragma unroll
        for (int i = 0; i < 4; ++i) {
            const int tt = half + 2 * i;
#pragma unroll
            for (int ks = 0; ks < 4; ++ks) {
                if (32 * ks <= 16 * tt + 15) {
                    const bf16x8 af = *(const bf16x8*)(wb + ((size_t)h * 128 + 16 * tt + l15) * 128 + 32 * ks + 8 * qd);
#pragma unroll
                    for (int nt = 0; nt < 4; ++nt) { const bf16x8 bf = *(const LAS bf16x8*)(vT + (64 * h + 16 * nt + l15) * GM_SV + 32 * ks + 8 * qd);
                        acc[i][nt] = __builtin_amdgcn_mfma_f32_16x16x32_bf16(af, bf, acc[i][nt], 0, 0, 0); }
                }
            }
        }
#pragma unroll
        for (int i = 0; i < 4; ++i)
#pragma unroll
            for (int rr = 0; rr < 4; ++rr) { const int t = 16 * (half + 2 * i) + 4 * qd + rr; const float bias = bs[i][rr]; float ss = 0.f;
#pragma unroll
                for (int nt = 0; nt < 4; ++nt) { const float u = gelu_tanh(bf2f(ur[i][rr][nt])); const float o = u * (acc[i][nt][rr] + bias); acc[i][nt][rr] = o; ss += o * o; }
                ss = row_sum16(ss);
                if (l15 == 0) part[t * 4 + h] = ss; }
        __syncthreads();
#pragma unroll
        for (int i = 0; i < 4; ++i)
#pragma unroll
            for (int rr = 0; rr < 4; ++rr) { const int t = 16 * (half + 2 * i) + 4 * qd + rr; const f32x4 pp = *(const LAS f32x4*)(part + t * 4);
                const float r = rsqf_(((pp.x + pp.y) + (pp.z + pp.w)) * (1.f / 256) + EPS);
#pragma unroll
                for (int nt = 0; nt < 4; ++nt) { const int cc = 64 * h + 16 * nt + l15; Y[(size_t)(t0 + t) * D + 256 + cc] = (bf16)f2bf(acc[i][nt][rr] * r * gn[cc]); } }
        __syncthreads();
    }
}
DI int gkk(int s, int q, int j) { return 32 * s + 16 * (j >> 2) + 4 * q + (j & 3); }
template <int PART, int R0, int NR> DI void gdn_conv_rows(const bf16* P, const float* cw, size_t t0, int n, int h, int lane, float (&y)[64], LAS bf16* tile) {
    const int ch = PART * 256 + h * 64 + lane;
    const float w0 = cw[0 * 768 + ch], w1 = cw[1 * 768 + ch], w2 = cw[2 * 768 + ch], w3 = cw[3 * 768 + ch];
    const bf16* src = P + (t0 + R0) * NP + PC_Q + ch;
    float p0 = 0.f, p1 = 0.f, p2 = 0.f;
    if (R0 > 0 || n > 0) { p0 = bf2f(*(src - 3 * (ptrdiff_t)NP)); p1 = bf2f(*(src - 2 * (ptrdiff_t)NP)); p2 = bf2f(*(src - (ptrdiff_t)NP)); }
    constexpr int CB = NR;
#pragma unroll
    for (int hb = 0; hb < NR / CB; ++hb) {
        unsigned short raw16[CB];
#pragma unroll
        for (int i = 0; i < CB; ++i) raw16[i] = *(const unsigned short*)(src + (size_t)(hb * CB + i) * NP);
        float raw[CB];
#pragma unroll
        for (int i = 0; i < CB; ++i) raw[i] = bf2f(raw16[i]);
#pragma unroll
        for (int i = 0; i < CB; ++i) {
            const float cur = raw[i];
            float v = siluf_(w0 * p0 + w1 * p1 + w2 * p2 + w3 * cur);
            p0 = p1; p1 = p2; p2 = cur;
            if (PART < 2) { const float ss = wave_sum(v * v); v *= (PART == 0 ? 0.125f : 1.0f) * rsqf_(ss + EPS); }
            if (PART > 0) y[R0 + hb * CB + i] = v;
            if (PART < 2) tile[(R0 + hb * CB + i) * 72 + lane] = (bf16)f2bf(v);
        }
    }
}
DI void gdn_prep_phase(Frame& F, int l) {
    const bf16* P = (const bf16*)(F.ws + WS_A); const float* AB = (const float*)(F.ws + WS_MISC + MS_AB); unsigned char* GOP = F.ws + WS_GOP; const float* cw = F.in[I_GCONV] + (size_t)l * 4 * 768;
    const int h = F.wave & 3, r = F.wave >> 2, lane = F.lane, l15 = lane & 15, q = lane >> 4;
    LAS unsigned char* hb = F.lds + h * 36608;
    LAS bf16* kt = (LAS bf16*)hb; LAS bf16* qt = (LAS bf16*)(hb + 9216); LAS float* At = (LAS float*)(hb + 18432);
    LAS float* Gs = (LAS float*)(hb + 18432 + 17408); LAS float* Bs = Gs + 64; LAS float* Es = Gs + 128;
    for (int item = F.vcu; item < NB * 128; item += F.G) {
        const int b = item >> 7, n = item & 127; const size_t t0 = (size_t)b * SEQ + (size_t)n * 64;
        unsigned char* ob = GOP + (size_t)((b * 4 + h) * 128 + n) * GOP_ISTRIDE;
        float x[64];
        if (r) { gdn_conv_rows<1, 0, 64>(P, cw, t0, n, h, lane, x, kt); gdn_conv_rows<0, 32, 32>(P, cw, t0, n, h, lane, x, qt); }
        else { gdn_conv_rows<2, 0, 64>(P, cw, t0, n, h, lane, x, kt); gdn_conv_rows<0, 0, 32>(P, cw, t0, n, h, lane, x, qt); }
        { const float av = AB[(t0 + lane) * 8 + h], bv = AB[(t0 + lane) * 8 + 4 + h];
          float g = -__expf(F.in[I_ALOG][l * 4 + h]) * softplusf_(av + F.in[I_DTB][l * 4 + h]); const float beta = sigmoidf_(bv);
#pragma unroll
          for (int o = 1; o < 64; o <<= 1) { const float t = __builtin_bit_cast(float, __builtin_amdgcn_ds_bpermute(4 * ((lane - o) & 63), __builtin_bit_cast(int, g))); if (lane >= o) g += t; }
          if (r) { Gs[lane] = g; Bs[lane] = beta; Es[lane] = beta * __expf(g); } }
        __syncthreads();
        bf16x8 kf[4][2];
#pragma unroll
        for (int a = 0; a < 4; ++a)
#pragma unroll
            for (int s2 = 0; s2 < 2; ++s2) kf[a][s2] = *(const LAS bf16x8*)(kt + (16 * a + l15) * 72 + 32 * s2 + 8 * q);
        if (r) {
#pragma unroll
            for (int a = 0; a < 4; ++a)
#pragma unroll
                for (int bb = 0; bb <= a; ++bb) {
                    f32x4 d = (f32x4){0.f, 0.f, 0.f, 0.f};
                    d = __builtin_amdgcn_mfma_f32_16x16x32_bf16(kf[a][0], kf[bb][0], d, 0, 0, 0);
                    d = __builtin_amdgcn_mfma_f32_16x16x32_bf16(kf[a][1], kf[bb][1], d, 0, 0, 0);
                    const int j = 16 * bb + l15; const float gj = Gs[j];
#pragma unroll
                    for (int rr = 0; rr < 4; ++rr) { const int i = 16 * a + 4 * q + rr; At[i * 68 + j] = (j < i) ? Bs[i] * d[rr] * __expf(Gs[i] - gj) : 0.f; }
                }
            const float g63 = Gs[63];
#pragma unroll
            for (int t = 0; t < 4; ++t)
#pragma unroll
                for (int s2 = 0; s2 < 2; ++s2) { float e[8];
#pragma unroll
                    for (int j = 0; j < 8; ++j) { const int c = gkk(s2, q, j); e[j] = bf2f(kt[c * 72 + 16 * t + l15]) * __expf(g63 - Gs[c]); }
                    u32x4 w; w.x = cvtpk(e[0], e[1]); w.y = cvtpk(e[2], e[3]); w.z = cvtpk(e[4], e[5]); w.w = cvtpk(e[6], e[7]);
                    *(u32x4*)(ob + 8192 + (t * 2 + s2) * 1024 + lane * 16) = w; }
            if (lane == 0) *(float*)(ob + 49152) = __expf(g63);
        } else {
#pragma unroll
            for (int i = 0; i < 4; ++i) {
                const bf16x8 qf0 = *(const LAS bf16x8*)(qt + (16 * i + l15) * 72 + 8 * q), qf1 = *(const LAS bf16x8*)(qt + (16 * i + l15) * 72 + 32 + 8 * q);
                const int c = 16 * i + l15; const float gc = Gs[c];
                float v[4][4];
#pragma unroll
                for (int a = 0; a < 4; ++a) {
                    if (a <= i) { f32x4 d = (f32x4){0.f, 0.f, 0.f, 0.f};
                        d = __builtin_amdgcn_mfma_f32_16x16x32_bf16(kf[a][0], qf0, d, 0, 0, 0);
                        d = __builtin_amdgcn_mfma_f32_16x16x32_bf16(kf[a][1], qf1, d, 0, 0, 0);
#pragma unroll
                        for (int rr = 0; rr < 4; ++rr) { const int cp = 16 * a + 4 * q + rr; v[a][rr] = (cp <= c) ? d[rr] * __expf(gc - Gs[cp]) : 0.f; }
                    } else {
                        float z0 = 0.f; asm volatile("" : "+v"(z0));
#pragma unroll
                        for (int rr = 0; rr < 4; ++rr) v[a][rr] = z0; }
                }
#pragma unroll
                for (int s2 = 0; s2 < 2; ++s2) { u32x4 w; w.x = cvtpk(v[2 * s2][0], v[2 * s2][1]); w.y = cvtpk(v[2 * s2][2], v[2 * s2][3]); w.z = cvtpk(v[2 * s2 + 1][0], v[2 * s2 + 1][1]); w.w = cvtpk(v[2 * s2 + 1][2], v[2 * s2 + 1][3]);
                    *(u32x4*)(ob + 24576 + (i * 2 + s2) * 1024 + lane * 16) = w; }
                const float eg = __expf(gc);
#pragma unroll
                for (int s2 = 0; s2 < 2; ++s2) { const u32x2 a0 = *(const LAS u32x2*)(qt + c * 72 + 32 * s2 + 4 * q), a1 = *(const LAS u32x2*)(qt + c * 72 + 32 * s2 + 16 + 4 * q);
                    u32x4 w; w.x = cvtpk(bf2f(a0.x & 0xffffu) * eg, bf2f(a0.x >> 16) * eg); w.y = cvtpk(bf2f(a0.y & 0xffffu) * eg, bf2f(a0.y >> 16) * eg);
                    w.z = cvtpk(bf2f(a1.x & 0xffffu) * eg, bf2f(a1.x >> 16) * eg); w.w = cvtpk(bf2f(a1.y & 0xffffu) * eg, bf2f(a1.y >> 16) * eg);
                    *(u32x4*)(ob + 16384 + (i * 2 + s2) * 1024 + lane * 16) = w; }
            }
        }
        __syncthreads();
        { LAS float* cf = r ? Es : Bs;
#pragma unroll
          for (int i = 0; i < 64; ++i) {
              float a0 = x[i] * cf[i], a1 = 0.f, a2 = 0.f, a3 = 0.f;
#pragma unroll
              for (int jb = 0; jb < (i + 3) / 4; ++jb) { const f32x4 a4 = *(const LAS f32x4*)(At + i * 68 + 4 * jb);
                  if (4 * jb + 0 < i) a0 -= a4[0] * x[4 * jb + 0];
                  if (4 * jb + 1 < i) a1 -= a4[1] * x[4 * jb + 1];
                  if (4 * jb + 2 < i) a2 -= a4[2] * x[4 * jb + 2];
                  if (4 * jb + 3 < i) a3 -= a4[3] * x[4 * jb + 3]; }
              x[i] = (a0 + a1) + (a2 + a3); } }
        if (r == 0) {
            float* wv = (float*)(ob + 32768); const int sl = lane >> 4, vl = lane & 15;
#pragma unroll
            for (int c = 0; c < 64; ++c) wv[((sl * 4 + (c >> 4)) * 64 + vl + 16 * ((c >> 2) & 3)) * 4 + (c & 3)] = x[c];
        } else {
#pragma unroll
            for (int c = 0; c < 64; ++c) kt[c * 72 + lane] = (bf16)f2bf(-x[c]);
            LDS_WAIT(); __builtin_amdgcn_wave_barrier();
#pragma unroll
            for (int i = 0; i < 4; ++i)
#pragma unroll
                for (int s2 = 0; s2 < 2; ++s2) { const int c = 16 * i + l15; const u32x2 a0 = *(const LAS u32x2*)(kt + c * 72 + 32 * s2 + 4 * q), a1 = *(const LAS u32x2*)(kt + c * 72 + 32 * s2 + 16 + 4 * q);
                    u32x4 w; w.x = a0.x; w.y = a0.y; w.z = a1.x; w.w = a1.y; *(u32x4*)(ob + (i * 2 + s2) * 1024 + lane * 16) = w; }
        }
        __syncthreads();
    }
}
DI void gdn_scan_phase(Frame& F, int l) {
    if (F.vcu >= 64) return;
    const int bh = F.vcu >> 2, sl = F.vcu & 3, b = bh >> 2, h = bh & 3, lane = F.lane, l15 = lane & 15, q = lane >> 4;
    const unsigned char* gsrc = F.ws + WS_GOP + (size_t)bh * 128 * GOP_ISTRIDE;
    bf16* O = (bf16*)(F.ws + WS_GO);
    constexpr int SLOT = 37 * 1024;
    const int w = F.wave;
#define GDN_ISSUE(n_) do { const unsigned char* cs_ = gsrc + (size_t)(n_) * GOP_ISTRIDE; LAS unsigned char* sd_ = F.lds + ((n_) & 3) * SLOT; \
        for (int p_ = w - 1; p_ < 37; p_ += 7) { const int so_ = (p_ < 32) ? p_ * 1024 : (p_ < 36) ? 32768 + sl * 4096 + (p_ - 32) * 1024 : 49152; \
            __builtin_amdgcn_global_load_lds((const unsigned*)(cs_ + so_ + lane * 16), (LAS unsigned*)(sd_ + p_ * 1024), 16, 0, 0); } } while (0)
    if (w > 0) { GDN_ISSUE(0); GDN_ISSUE(1); GDN_ISSUE(2); }
    f32x4 S[4];
#pragma unroll
    for (int t = 0; t < 4; ++t) S[t] = (f32x4){0.f, 0.f, 0.f, 0.f};
    for (int n = 0; n < 128; ++n) {
        if (w > 0) {
            if (n == 127) { asm volatile("s_waitcnt vmcnt(0)" ::: "memory"); }
            else if (n == 126) { if (w <= 2) { asm volatile("s_waitcnt vmcnt(6)" ::: "memory"); } else { asm volatile("s_waitcnt vmcnt(5)" ::: "memory"); } }
            else if (w <= 2) { asm volatile("s_waitcnt vmcnt(12)" ::: "memory"); } else { asm volatile("s_waitcnt vmcnt(10)" ::: "memory"); } }
        asm volatile("s_waitcnt lgkmcnt(0)" ::: "memory");
        __builtin_amdgcn_s_barrier();
        asm volatile("" ::: "memory");
        if (w > 0) { if (n + 3 < 128) GDN_ISSUE(n + 3); }
        else {
            const LAS unsigned char* sd = F.lds + (n & 3) * SLOT;
            f32x4 wv[4]; bf16x8 fr[4][8];
#pragma unroll
            for (int i = 0; i < 4; ++i) wv[i] = *(const LAS f32x4*)(sd + 32768 + i * 1024 + lane * 16);
#pragma unroll
            for (int blk = 0; blk < 4; ++blk)
#pragma unroll
                for (int f = 0; f < 8; ++f) fr[blk == 1 ? 1 : (blk == 0 ? 0 : blk)][f] = *(const LAS bf16x8*)(sd + blk * 8192 + f * 1024 + lane * 16);
            const float gt = *(const LAS float*)(sd + 36 * 1024);
            __builtin_amdgcn_sched_barrier(0);
#define GFRAG(blk, f) (fr[blk][f])
            u32x4 sf[2], uf[2];
#pragma unroll
            for (int s2 = 0; s2 < 2; ++s2) { sf[s2].x = cvtpk(S[2 * s2][0], S[2 * s2][1]); sf[s2].y = cvtpk(S[2 * s2][2], S[2 * s2][3]); sf[s2].z = cvtpk(S[2 * s2 + 1][0], S[2 * s2 + 1][1]); sf[s2].w = cvtpk(S[2 * s2 + 1][2], S[2 * s2 + 1][3]); }
            f32x4 U[4];
#pragma unroll
            for (int i = 0; i < 4; ++i) { U[i] = wv[i];
                U[i] = __builtin_amdgcn_mfma_f32_16x16x32_bf16(GFRAG(0, i * 2 + 0), __builtin_bit_cast(bf16x8, sf[0]), U[i], 0, 0, 0);
                U[i] = __builtin_amdgcn_mfma_f32_16x16x32_bf16(GFRAG(0, i * 2 + 1), __builtin_bit_cast(bf16x8, sf[1]), U[i], 0, 0, 0); }
#pragma unroll
            for (int s2 = 0; s2 < 2; ++s2) { uf[s2].x = cvtpk(U[2 * s2][0], U[2 * s2][1]); uf[s2].y = cvtpk(U[2 * s2][2], U[2 * s2][3]); uf[s2].z = cvtpk(U[2 * s2 + 1][0], U[2 * s2 + 1][1]); uf[s2].w = cvtpk(U[2 * s2 + 1][2], U[2 * s2 + 1][3]); }
#pragma unroll
            for (int t = 0; t < 4; ++t) { S[t] = S[t] * gt;
                S[t] = __builtin_amdgcn_mfma_f32_16x16x32_bf16(GFRAG(1, t * 2 + 0), __builtin_bit_cast(bf16x8, uf[0]), S[t], 0, 0, 0);
                S[t] = __builtin_amdgcn_mfma_f32_16x16x32_bf16(GFRAG(1, t * 2 + 1), __builtin_bit_cast(bf16x8, uf[1]), S[t], 0, 0, 0); }
            const size_t row0 = (size_t)b * SEQ + (size_t)n * 64;
#pragma unroll
            for (int i = 0; i < 4; ++i) { f32x4 o = (f32x4){0.f, 0.f, 0.f, 0.f};
                o = __builtin_amdgcn_mfma_f32_16x16x32_bf16(GFRAG(2, i * 2 + 0), __builtin_bit_cast(bf16x8, sf[0]), o, 0, 0, 0);
                o = __builtin_amdgcn_mfma_f32_16x16x32_bf16(GFRAG(2, i * 2 + 1), __builtin_bit_cast(bf16x8, sf[1]), o, 0, 0, 0);
                o = __builtin_amdgcn_mfma_f32_16x16x32_bf16(GFRAG(3, i * 2 + 0), __builtin_bit_cast(bf16x8, uf[0]), o, 0, 0, 0);
                o = __builtin_amdgcn_mfma_f32_16x16x32_bf16(GFRAG(3, i * 2 + 1), __builtin_bit_cast(bf16x8, uf[1]), o, 0, 0, 0);
#pragma unroll
                for (int rr = 0; rr < 4; ++rr) O[(row0 + 16 * i + 4 * q + rr) * 256 + h * 64 + sl * 16 + l15] = (bf16)f2bf(o[rr]); }
#undef GFRAG
        }
    }
#undef GDN_ISSUE
    asm volatile("s_waitcnt vmcnt(0) lgkmcnt(0)" ::: "memory");
    __builtin_amdgcn_s_barrier();
}
DI void gdn_finish_phase(Frame& F, int l) {
    const bf16* P = (const bf16*)(F.ws + WS_A); const bf16* O = (const bf16*)(F.ws + WS_GO); bf16* Y = (bf16*)(F.ws + WS_B);
    const int c = F.lane * 4;
    const f32x4 gn = *(const f32x4*)(F.in[I_GDNN] + l * 64 + (c & 63));
    for (int m0 = F.gw; m0 < T; m0 += 4 * F.NGW) {
      u32x2 ov4[4], zv4[4];
#pragma unroll
      for (int r = 0; r < 4; ++r) { const int m = m0 + r * F.NGW; ov4[r] = *(const u32x2*)(O + (size_t)m * 256 + c); zv4[r] = *(const u32x2*)(P + (size_t)m * NP + PC_Z + c); }
#pragma unroll
      for (int r = 0; r < 4; ++r) {
        const int m = m0 + r * F.NGW; const u32x2 ov = ov4[r], zv = zv4[r];
        float o[4] = {bf2f(ov.x & 0xffffu), bf2f(ov.x >> 16), bf2f(ov.y & 0xffffu), bf2f(ov.y >> 16)};
        const float z[4] = {bf2f(zv.x & 0xffffu), bf2f(zv.x >> 16), bf2f(zv.y & 0xffffu), bf2f(zv.y >> 16)};
        float ss = (o[0] * o[0] + o[1] * o[1]) + (o[2] * o[2] + o[3] * o[3]);
        ss = row_sum16(ss);
        const float rs = rsqf_(ss * (1.f / 64) + EPS);
        u32x2 w; w.x = pk2(o[0] * rs * gn.x * siluf_(z[0]), o[1] * rs * gn.y * siluf_(z[1])); w.y = pk2(o[2] * rs * gn.z * siluf_(z[2]), o[3] * rs * gn.w * siluf_(z[3]));
        *(u32x2*)(Y + (size_t)m * D + 512 + c) = w;
      }
    }
}
constexpr int S5_SS = 136, S5_YS = 264;
struct S5Consts { float ar, ai; bf16x8 bfr[8]; };
DI void s5_load_consts(Frame& F, int l, int g, S5Consts& K) {
    const float* SM = (const float*)(F.ws + WS_SMALL);
    const int si = (l * 16 + g) * 64 + F.lane, l15 = F.lane & 15, qd = F.lane >> 4;
    K.ar = SM[SM_AR + si]; K.ai = SM[SM_AI + si];
#pragma unroll
    for (int nt = 0; nt < 8; ++nt) {
        u32x4 w = (u32x4){0u, 0u, 0u, 0u};
        if (qd < 2) { const int np = 16 * nt + l15; const float* src = SM + ((np < 64) ? SM_BBR : SM_BBI) + (size_t)((l * 16 + g) * 64 + (np & 63)) * 16 + 8 * qd;
            const f32x4 x0 = *(const f32x4*)src, x1 = *(const f32x4*)(src + 4); w.x = cvtpk(x0.x, x0.y); w.y = cvtpk(x0.z, x0.w); w.z = cvtpk(x1.x, x1.y); w.w = cvtpk(x1.z, x1.w); }
        K.bfr[nt] = __builtin_bit_cast(bf16x8, w);
    }
}
DI u32x4 s5_load_u(const bf16* ub, int l15, int qd) {
    const u32x4 v = *(const u32x4*)(ub + (size_t)l15 * NP + 8 * (qd & 1)); const unsigned m = (qd < 2) ? 0xffffffffu : 0u; return (u32x4){v.x & m, v.y & m, v.z & m, v.w & m}; }
constexpr int S5_BT = 48;
template <bool OUT> DI void s5_block16(Frame& F, const S5Consts& K, const u32x4 uw, float& sr, float& sim, LAS unsigned char* scr) {
    const int l15 = F.lane & 15, qd = F.lane >> 4;
    const bf16x8 uf = __builtin_bit_cast(bf16x8, uw);
    f32x4 d[8];
#pragma unroll
    for (int nt = 0; nt < 8; ++nt) d[nt] = __builtin_amdgcn_mfma_f32_16x16x32_bf16(uf, K.bfr[nt], (f32x4){0.f, 0.f, 0.f, 0.f}, 0, 0, 0);
    __builtin_amdgcn_sched_barrier(0);
#pragma unroll
    for (int nt = 0; nt < 8; ++nt) { u32x2 w; w.x = cvtpk(d[nt][0], d[nt][1]); w.y = cvtpk(d[nt][2], d[nt][3]); *(LAS u32x2*)(scr + (16 * nt + l15) * S5_BT + 8 * qd) = w; }
    LDS_WAIT(); __builtin_amdgcn_wave_barrier();
    __builtin_amdgcn_sched_barrier(0);
    unsigned rw[8], iw[8];
    { const u32x4 r0 = *(const LAS u32x4*)(scr + F.lane * S5_BT), r1 = *(const LAS u32x4*)(scr + F.lane * S5_BT + 16);
      const u32x4 i0 = *(const LAS u32x4*)(scr + (64 + F.lane) * S5_BT), i1 = *(const LAS u32x4*)(scr + (64 + F.lane) * S5_BT + 16);
      rw[0] = r0.x; rw[1] = r0.y; rw[2] = r0.z; rw[3] = r0.w; rw[4] = r1.x; rw[5] = r1.y; rw[6] = r1.z; rw[7] = r1.w;
      iw[0] = i0.x; iw[1] = i0.y; iw[2] = i0.z; iw[3] = i0.w; iw[4] = i1.x; iw[5] = i1.y; iw[6] = i1.z; iw[7] = i1.w; }
    LDS_WAIT(); __builtin_amdgcn_wave_barrier();
    float hr[16], hi[16];
#pragma unroll
    for (int t = 0; t < 16; ++t) {
        const float br = __uint_as_float((t & 1) ? (rw[t >> 1] & 0xffff0000u) : (rw[t >> 1] << 16)), bi = __uint_as_float((t & 1) ? (iw[t >> 1] & 0xffff0000u) : (iw[t >> 1] << 16));
        const float nr = K.ar * sr - K.ai * sim + br, ni = K.ar * sim + K.ai * sr + bi; sr = nr; sim = ni;
        hr[t] = sr; hi[t] = sim;
    }
    if (OUT) {
#pragma unroll
        for (int t = 0; t < 16; ++t) *(LAS unsigned*)(scr + t * (S5_SS * 2) + 4 * F.lane) = cvtpk(hr[t], hi[t]);
        LDS_WAIT(); __builtin_amdgcn_wave_barrier();
    }
}
DI void s5_pass1_phase(Frame& F, int l) {
    const bf16* P = (const bf16*)(F.ws + WS_A); float* E = (float*)(F.ws + WS_MISC + MS_E);
    LAS unsigned char* scr = F.lds + F.wave * 8704;
    for (int it = F.gw; it < NB * 16 * S5NC; it += F.NGW) {
        const int c = it % S5NC, g = (it / S5NC) & 15, b = it / (S5NC * 16);
        S5Consts K; s5_load_consts(F, l, g, K);
        float sr = 0.f, sim = 0.f;
        const bf16* up = P + ((size_t)b * SEQ + (size_t)c * S5CS) * NP + PC_S5 + g * 16;
        u32x4 uw8[S5CS / 16];
#pragma unroll
        for (int tb = 0; tb < S5CS / 16; ++tb) uw8[tb] = s5_load_u(up + (size_t)tb * 16 * NP, F.lane & 15, F.lane >> 4);
        asm volatile("s_waitcnt vmcnt(0)" ::: "memory");
#pragma unroll
        for (int tb = 0; tb < S5CS / 16; ++tb) s5_block16<false>(F, K, uw8[tb], sr, sim, scr);
        float* e = E + ((size_t)(b * 16 + g) * S5NC + c) * 128;
        e[F.lane] = sr; e[64 + F.lane] = sim;
    }
}
DI void s5_pass3_phase(Frame& F, int l, int wg0, int nwg) {
    const bf16* P = (const bf16*)(F.ws + WS_A); const float* SM = (const float*)(F.ws + WS_SMALL); const float* E = (const float*)(F.ws + WS_MISC + MS_E); bf16* Y = (bf16*)(F.ws + WS_B);
    LAS bf16* yt = (LAS bf16*)(F.lds + 69632);
    LAS unsigned char* scr = F.lds + F.wave * 8704;
    LAS float* part = (LAS float*)(F.lds + 67584 + 8 * 8704);
    const float* cre = F.in[I_CRE] + (size_t)l * 16 * 16 * 64; const float* cim = F.in[I_CIM] + (size_t)l * 16 * 16 * 64;
    const float* dsk = F.in[I_S5D] + l * 256;
    const int l15 = F.lane & 15, qd = F.lane >> 4;
    for (int it = wg0; it < NB * S5NC; it += nwg) {
        const int b = it / S5NC, c = it % S5NC;
        const size_t row0 = (size_t)b * SEQ + (size_t)c * S5CS;
#pragma unroll 4
        for (int k2 = 0; k2 < 8; ++k2) { const int id = F.tid + NTHR * k2, rw = id >> 5, c16 = id & 31;
            *(LAS u32x4*)(yt + rw * S5_YS + c16 * 8) = *(const u32x4*)(P + (row0 + rw) * NP + PC_S5 + c16 * 8); }
        __syncthreads();
        for (int gi = 0; gi < 2; ++gi) {
            const int g = F.wave * 2 + gi;
            S5Consts K; s5_load_consts(F, l, g, K);
            const int si = (l * 16 + g) * 64 + F.lane;
            const float pr = SM[SM_PR + si], pi = SM[SM_PI + si];
            float sr = 0.f, sim = 0.f;
            const float* e = E + (size_t)(b * 16 + g) * S5NC * 128;
            for (int cc0 = 0; cc0 < c; cc0 += 8) {
                float er[8], ei[8];
#pragma unroll
                for (int k2 = 0; k2 < 8; ++k2) { const int cc = (cc0 + k2 < c) ? cc0 + k2 : c - 1; er[k2] = e[cc * 128 + F.lane]; ei[k2] = e[cc * 128 + 64 + F.lane]; }
#pragma unroll
                for (int k2 = 0; k2 < 8; ++k2) if (cc0 + k2 < c) { const float nr = pr * sr - pi * sim + er[k2], ni = pr * sim + pi * sr + ei[k2]; sr = nr; sim = ni; }
            }
            bf16x8 cfr[4];
#pragma unroll
            for (int s2 = 0; s2 < 4; ++s2) { const size_t o = ((size_t)g * 16 + l15) * 64 + 16 * s2 + 4 * qd; const f32x4 cr = *(const f32x4*)(cre + o), ci = *(const f32x4*)(cim + o);
                u32x4 w; w.x = cvtpk(cr.x, -ci.x); w.y = cvtpk(cr.y, -ci.y); w.z = cvtpk(cr.z, -ci.z); w.w = cvtpk(cr.w, -ci.w); cfr[s2] = __builtin_bit_cast(bf16x8, w); }
            const float dch = dsk[g * 16 + l15];
            const bf16* up = P + row0 * NP + PC_S5 + g * 16;
            for (int tb = 0; tb < S5CS / 16; ++tb) {
                u32x4 uw = *(const LAS u32x4*)(yt + (tb * 16 + l15) * S5_YS + g * 16 + 8 * (qd & 1));
                { const unsigned msk = (qd < 2) ? 0xffffffffu : 0u; uw.x &= msk; uw.y &= msk; uw.z &= msk; uw.w &= msk; }
                float uu4[4];
#pragma unroll
                for (int rr = 0; rr < 4; ++rr) uu4[rr] = bf2f(yt[(tb * 16 + 4 * qd + rr) * S5_YS + g * 16 + l15]);
                LDS_WAIT(); __builtin_amdgcn_wave_barrier();
                s5_block16<true>(F, K, uw, sr, sim, scr);
                f32x4 acc = (f32x4){0.f, 0.f, 0.f, 0.f};
#pragma unroll
                for (int s2 = 0; s2 < 4; ++s2) { const bf16x8 af = *(const LAS bf16x8*)((LAS bf16*)scr + l15 * S5_SS + 32 * s2 + 8 * qd); acc = __builtin_amdgcn_mfma_f32_16x16x32_bf16(af, cfr[s2], acc, 0, 0, 0); }
#pragma unroll
                for (int rr = 0; rr < 4; ++rr) { const int t = tb * 16 + 4 * qd + rr;
                    yt[t * S5_YS + g * 16 + l15] = (bf16)f2bf(gelu_tanh(acc[rr] + dch * uu4[rr])); }
                LDS_WAIT(); __builtin_amdgcn_wave_barrier();
            }
        }
        __syncthreads();
        {
            const bf16* wt = (const bf16*)(F.ws + WS_WGLU) + (size_t)l * 65536;
            f32x4 acc[8][2];
#pragma unroll
            for (int tt = 0; tt < 8; ++tt) { acc[tt][0] = (f32x4){0.f, 0.f, 0.f, 0.f}; acc[tt][1] = (f32x4){0.f, 0.f, 0.f, 0.f}; }
#pragma unroll
            for (int s2 = 0; s2 < 8; ++s2) {
                const bf16x8 b0 = *(const bf16x8*)(wt + (size_t)(32 * F.wave + l15) * 256 + 32 * s2 + 8 * qd), b1 = *(const bf16x8*)(wt + (size_t)(32 * F.wave + 16 + l15) * 256 + 32 * s2 + 8 * qd);
#pragma unroll
                for (int tt = 0; tt < 8; ++tt) { const bf16x8 af = *(const LAS bf16x8*)(yt + (16 * tt + l15) * S5_YS + 32 * s2 + 8 * qd);
                    acc[tt][0] = __builtin_amdgcn_mfma_f32_16x16x32_bf16(af, b0, acc[tt][0], 0, 0, 0); acc[tt][1] = __builtin_amdgcn_mfma_f32_16x16x32_bf16(af, b1, acc[tt][1], 0, 0, 0); }
            }
            const int n0 = 32 * F.wave + l15;
            const float bg0 = F.in[I_BGLU][l * 256 + n0], bg1 = F.in[I_BGLU][l * 256 + n0 + 16], gn0 = F.in[I_S5N][l * 256 + n0], gn1 = F.in[I_S5N][l * 256 + n0 + 16];
#pragma unroll
            for (int tt = 0; tt < 8; ++tt)
#pragma unroll
                for (int rr = 0; rr < 4; ++rr) { const int t = 16 * tt + 4 * qd + rr;
                    const float o0 = bf2f(yt[t * S5_YS + n0]) * sigmoidf_(acc[tt][0][rr] + bg0), o1 = bf2f(yt[t * S5_YS + n0 + 16]) * sigmoidf_(acc[tt][1][rr] + bg1);
                    acc[tt][0][rr] = o0; acc[tt][1][rr] = o1;
                    float ss = o0 * o0 + o1 * o1; ss = row_sum16(ss);
                    if (l15 == 0) part[t * 8 + F.wave] = ss; }
            __syncthreads();
#pragma unroll
            for (int tt = 0; tt < 8; ++tt)
#pragma unroll
                for (int rr = 0; rr < 4; ++rr) { const int t = 16 * tt + 4 * qd + rr; const f32x4 p0 = *(const LAS f32x4*)(part + t * 8), p1 = *(const LAS f32x4*)(part + t * 8 + 4);
                    const float r = rsqf_((((p0.x + p0.y) + (p0.z + p0.w)) + ((p1.x + p1.y) + (p1.z + p1.w))) * (1.f / 256) + EPS);
                    const unsigned w = cvtpk(acc[tt][0][rr] * r * gn0, acc[tt][1][rr] * r * gn1); Y[(row0 + t) * D + n0] = (bf16)w; Y[(row0 + t) * D + n0 + 16] = (bf16)(w >> 16); }
        }
        __syncthreads();
    }
}


DI void moe_slot_phase(Frame& F) {
    LAS int* le = (LAS int*)F.lds;
    const int* TE = (const int*)(F.ws + WS_MISC + MS_TE); const int* CNT = (const int*)(F.ws + WS_MISC + MS_CNT);
    int* TS = (int*)(F.ws + WS_MISC + MS_TS); int* ST = (int*)(F.ws + WS_MISC + MS_ST); int* SEG = (int*)(F.ws + WS_MISC + MS_SEG);
    for (int w = F.vcu; w < 256; w += F.G) {
        LAS int* lcnt = le + 512;
        if (F.tid < 256) { const u32x4 a = *(const u32x4*)(CNT + F.tid * 8), b4 = *(const u32x4*)(CNT + F.tid * 8 + 4);
            *(LAS u32x4*)(lcnt + F.tid * 8) = a; *(LAS u32x4*)(lcnt + F.tid * 8 + 4) = b4; le[F.tid] = TE[(size_t)w * 256 + F.tid]; }
        __syncthreads();
        if (F.tid < 8) {
            int tot = 0, pre = 0;
#pragma unroll 16
            for (int ww = 0; ww < 256; ++ww) { const int cnt = lcnt[ww * 8 + F.tid]; tot += cnt; if (ww < w) pre += cnt; }
            le[256 + F.tid] = pre; le[264 + F.tid] = tot;
        }
        __syncthreads();
        if (F.tid == 0) { int s = 0; for (int e = 0; e < 8; ++e) { le[272 + e] = s; s += (le[264 + e] + 255) & ~255; } le[280] = s; }
        __syncthreads();
        if (F.tid < 256) {
            const int e = le[F.tid]; int rank = 0;
            for (int j = 0; j < F.tid; ++j) rank += (le[j] == e) ? 1 : 0;
            const int slot = le[272 + e] + le[256 + e] + rank;
            TS[(size_t)w * 256 + F.tid] = slot; ST[slot] = w * 128 + (F.tid >> 1);
        }
        if (w == 0) {
            if (F.tid < 9) SEG[F.tid] = le[272 + F.tid];
            if (F.tid == 9) SEG[9] = le[280] >> 8;
            for (int e = 0; e < 8; ++e) { const int s0 = le[272 + e] + le[264 + e], s1 = le[272 + e + 1]; for (int s = s0 + F.tid; s < s1; s += NTHR) ST[s] = 0; }
        }
        __syncthreads();
    }
}
DI void moe_combine_final_phase(Frame& F) {
    const float* TG = (const float*)(F.ws + WS_MISC + MS_TG); const int* TS = (const int*)(F.ws + WS_MISC + MS_TS);
    const bf16* Y0 = (const bf16*)(F.ws + WS_YB0); const bf16* Y1 = (const bf16*)(F.ws + WS_B);
    const float* gain = F.in[I_FINN];
    f32x4 gv[4];
#pragma unroll
    for (int j = 0; j < 4; ++j) gv[j] = *(const f32x4*)(gain + 4 * F.lane + 256 * j);
    for (int m0 = F.gw; m0 < T; m0 += 2 * F.NGW) {
        u32x2 hh[2][4], ya[2][4], yb[2][4]; float g0[2], g1[2];
#pragma unroll
        for (int r = 0; r < 2; ++r) { const int m = m0 + r * F.NGW;
            const u32x2 ss = *(const u32x2*)(TS + (size_t)m * 2); const f32x2 gg = *(const f32x2*)(TG + (size_t)m * 2); g0[r] = gg.x; g1[r] = gg.y;
            const int s0 = (int)ss.x, s1 = (int)ss.y;
            const bf16* y0 = (s0 < 32768) ? Y0 + (size_t)s0 * D : Y1 + (size_t)(s0 - 32768) * D;
            const bf16* y1 = (s1 < 32768) ? Y0 + (size_t)s1 * D : Y1 + (size_t)(s1 - 32768) * D;
            const u32x2* hr = (const u32x2*)((const bf16*)(F.ws + WS_H) + (size_t)m * D) + F.lane;
#pragma unroll
            for (int j = 0; j < 4; ++j) { hh[r][j] = hr[64 * j]; ya[r][j] = *((const u32x2*)y0 + F.lane + 64 * j); yb[r][j] = *((const u32x2*)y1 + F.lane + 64 * j); } }
#pragma unroll
        for (int r = 0; r < 2; ++r) { const int m = m0 + r * F.NGW;
            f32x4* xr = (f32x4*)(F.out + (size_t)m * D) + F.lane;
            f32x4 v[4]; float s = 0.f;
#pragma unroll
            for (int j = 0; j < 4; ++j) { const u32x2 h2 = hh[r][j], a = ya[r][j], bq = yb[r][j];
                v[j].x = bf2f(h2.x & 0xffffu) + (g0[r] * bf2f(a.x & 0xffffu) + g1[r] * bf2f(bq.x & 0xffffu)); v[j].y = bf2f(h2.x >> 16) + (g0[r] * bf2f(a.x >> 16) + g1[r] * bf2f(bq.x >> 16));
                v[j].z = bf2f(h2.y & 0xffffu) + (g0[r] * bf2f(a.y & 0xffffu) + g1[r] * bf2f(bq.y & 0xffffu)); v[j].w = bf2f(h2.y >> 16) + (g0[r] * bf2f(a.y >> 16) + g1[r] * bf2f(bq.y >> 16));
                s += (v[j].x * v[j].x + v[j].y * v[j].y) + (v[j].z * v[j].z + v[j].w * v[j].w); }
            const float rstd = rsqf_(wave_sum(s) * (1.f / D) + EPS);
#pragma unroll
            for (int j = 0; j < 4; ++j) xr[64 * j] = v[j] * rstd * gv[j]; }
    }
}

constexpr size_t HID_BYTES = (size_t)PASSP * 256 * DFE;
static_assert(HID_BYTES <= WS_B - WS_A, "hidden buffer");
constexpr size_t HID1_OFF = (size_t)T * D;
constexpr int NSTEPS = 25;
__global__ void __launch_bounds__(NTHR, 2) mk_fwd(Params prm) {
    extern __shared__ __attribute__((aligned(16))) unsigned char lds_raw[];
    Frame F;
    F.lds = (LAS unsigned char*)lds_raw; F.MISC = (volatile LAS unsigned*)(F.lds + MISC_OFF);
    F.tid = threadIdx.x; F.lane = F.tid & 63; F.wave = __builtin_amdgcn_readfirstlane(F.tid >> 6);
    F.G = gridDim.x; { const int bx = blockIdx.x; F.vcu = (F.G % 8 == 0) ? (bx % 8) * (F.G / 8) + bx / 8 : bx; }
    F.gw = F.vcu * NWAVES + F.wave; F.NGW = F.G * NWAVES;
    F.in = prm.in; F.out = prm.out; F.ws = prm.ws;
    for (int u = F.tid; u < (LDS_BYTES - LDSCTL_OFF) / 4; u += NTHR) ((LAS unsigned*)(F.lds + LDSCTL_OFF))[u] = 0u;
    __syncthreads();
    const int wave0 = __builtin_amdgcn_readfirstlane(threadIdx.x >> 6);
    const int lo = prm.s_lo, hi = prm.s_hi;
    XcdBarrier bar; bar.bar = (unsigned*)(F.ws + WS_CTL) + CW_BAR; bar.x = 0; bar.st = nullptr;
    if (hi - lo > 1) bar = xcd_barrier_post((unsigned*)(F.ws + WS_CTL) + CW_BAR, F.MISC + 8);
#define ENTER() do { int _t, _b = blockIdx.x; asm volatile("v_mbcnt_lo_u32_b32 %0, -1, 0\n v_mbcnt_hi_u32_b32 %0, -1, %0" : "=v"(_t)); _t |= wave0 << 6; asm volatile("" : "+s"(_b));     F.tid = _t; F.lane = _t & 63; F.wave = __builtin_amdgcn_readfirstlane(_t >> 6); \
        F.bid = _b; F.vcu = (F.G % 8 == 0) ? (_b % 8) * (F.G / 8) + _b / 8 : _b; F.gw = F.vcu * NWAVES + F.wave; } while (0)
#define RUN(s) (lo <= (s) && (s) < hi)
#define SEAM(s) do { if (RUN(s) && RUN((s) + 1)) xcd_barrier(bar); } while (0)
    bf16* Hb = (bf16*)F.out; bf16* Rb = (bf16*)(F.ws + WS_H); bf16* Pb = (bf16*)(F.ws + WS_A); bf16* Yb = (bf16*)(F.ws + WS_B);
#define PHASE(k, ...) do { if constexpr (PH(k)) { for (int rp_ = 0; rp_ < REPS(k); ++rp_) { if (rp_) __syncthreads(); ENTER(); __VA_ARGS__; } } } while (0)
    if (RUN(0)) { PHASE(0, p0_prologue(F)); __syncthreads(); PHASE(1, norm_phase<0, false>(F, F.in[I_X], F.in[I_MIXN], 0)); }
    SEAM(0);
    for (int l = 0; l < 2; ++l) {
        const int sb = 1 + 9 * l;
        if (l > 0) { if (RUN(sb + 0)) PHASE(1, norm_phase<0, true>(F, Rb, F.in[I_MIXN] + l * D, l)); SEAM(sb + 0); }
        if (RUN(sb + 1)) PHASE(2, {
            pg8::DenseOrder S{T / 256, NP / 256, F.G, F.bid, D, (const bf16*)(F.ws + WS_WIN) + (size_t)l * NP * D};
            pg8::EpiStoreBf16 E{Pb, NP, 0, nullptr, 0};
            pg8::gemm_phase<pg8::EpiStoreBf16, pg8::DenseOrder, D, false, true, true>(F.lds, F.tid, Hb, nullptr, nullptr, S, E); });
        SEAM(sb + 1);
        if (RUN(sb + 2)) { PHASE(6, gdn_prep_phase(F, l)); __syncthreads(); PHASE(7, s5_pass1_phase(F, l)); }
        SEAM(sb + 2);
        if (RUN(sb + 3)) {
            PHASE(19, gdn_scan_phase(F, l));
            unsigned* qh = (unsigned*)(F.ws + WS_CTL) + 1024 + 64 * l;
            for (;;) {
                __syncthreads();
                if (F.tid == 0) F.MISC[16] = __hip_atomic_fetch_add(qh, 1u, __ATOMIC_RELAXED, __HIP_MEMORY_SCOPE_AGENT);
                __syncthreads();
                const int id = (int)F.MISC[16];
                if (id >= 768) break;
                if (id < 256) { PHASE(8, s5_pass3_phase(F, l, id, 1 << 20)); }
                else if (id < 512) { PHASE(4, gmlp_phase(F, l, id - 256, 1 << 20)); }
                else { PHASE(3, shortconv_phase(F, l, id - 512, 256)); }
            }
        }
        SEAM(sb + 3);
        if (RUN(sb + 4)) PHASE(20, gdn_finish_phase(F, l));
        SEAM(sb + 4);
        if (RUN(sb + 5)) PHASE(9, {
            pg8::DenseOrder S{T / 256, D / 256, F.G, F.bid, D, (const bf16*)(F.ws + WS_WOUT) + (size_t)l * D * D};
            if (l == 0) { pg8::EpiResBf16<true> E{F.in[I_X], Rb, D, 1.f};
                pg8::gemm_phase<pg8::EpiResBf16<true>, pg8::DenseOrder, D, false, true, true>(F.lds, F.tid, Yb, nullptr, nullptr, S, E); }
            else { pg8::EpiResBf16<false> E{Rb, Rb, D, 1.f};
                pg8::gemm_phase<pg8::EpiResBf16<false>, pg8::DenseOrder, D, false, true, true>(F.lds, F.tid, Yb, nullptr, nullptr, S, E); } });
        SEAM(sb + 5);
        if (l == 0) {
            if (RUN(sb + 6)) PHASE(10, norm_phase<1, true>(F, Rb, F.in[I_FFNN], 0));
            SEAM(sb + 6);
            if (RUN(sb + 7)) PHASE(11, {
                pg8::DenseOrder S{T / 256, 2 * DFF / 256, F.G, F.bid, D / 2, (const bf16*)(F.ws + WS_WGU)};
                pg8::EpiSwigluF8 E{(unsigned char*)Pb, DFF, 1.f / (F8_SA * F8_SW), F8_SH};
                pg8::gemm_phase<pg8::EpiSwigluF8, pg8::DenseOrder, D / 2, false, true, true, true>(F.lds, F.tid, Hb, nullptr, nullptr, S, E); });
            SEAM(sb + 7);
            if (RUN(sb + 8)) PHASE(12, {
                pg8::DenseOrder S{T / 256, D / 256, F.G, F.bid, DFF / 2, (const bf16*)(F.ws + WS_WDN)};
                pg8::EpiResBf16<false, true> E{Rb, Rb, D, 1.f / (F8_SH * F8_SWD)};
                pg8::gemm_phase<pg8::EpiResBf16<false, true>, pg8::DenseOrder, DFF / 2, false, true, true, true>(F.lds, F.tid, Pb, nullptr, nullptr, S, E); });
            SEAM(sb + 8);
        } else {
            if (RUN(sb + 6)) { PHASE(13, norm_phase<2, true>(F, Rb, F.in[I_FFNN] + D, 1)); __syncthreads(); PHASE(21, p0_moe_weights(F)); }
            SEAM(sb + 6);
            if (RUN(sb + 7)) PHASE(15, moe_slot_phase(F));
            SEAM(sb + 7);
            const int* SEG = (const int*)(F.ws + WS_MISC + MS_SEG);
            for (int k = 0; k < 3; ++k) {
                const int s0 = 18 + k;
                if (RUN(s0)) {
                    const int npan = SEG[9];
                    int nlong = 0;
                    if (k >= 1) {
                        const int ps = k - 1;
                        const int nM = ps < 1 ? PASSP : npan - PASSP, p0 = ps * PASSP;
                        nlong = 4 * nM;
                        const bf16* Ah = ps == 0 ? (const bf16*)(F.ws + WS_A) : (const bf16*)((const unsigned char*)F.out + HID1_OFF);
                        if (nM > 0) PHASE(17, {
                            pg8::MoeOrder S{nM, D / 256, F.G, F.bid, DFE / 2, p0, (const bf16*)(F.ws + WS_MDN), (size_t)D * (DFE / 2), SEG, true, 0, 0};
                            pg8::EpiStoreBf16S E{(bf16*)(F.ws + WS_YB0), D, p0, Yb, 32768, 1.f / (F8_SH * F8_SWD)};
                            pg8::gemm_phase<pg8::EpiStoreBf16S, pg8::MoeOrder, DFE / 2, false, true, true, true>(F.lds, F.tid, Ah, nullptr, nullptr, S, E); });
                    }
                    if (k <= 1) {
                        const int ps = k;
                        const int nM = ps < 1 ? PASSP : npan - PASSP, p0 = ps * PASSP;
                        int nx = 0, na = 0;
                        if (nlong > F.G && (nlong & 255) != 0 && F.G == 256) {
                            nx = ((nlong & 255) + 7) & ~7; const int R = 256 - nx, ns = nM * (2 * DFE / 256);
                            int a0 = (2 * ns - 7 * R) / 512; if (a0 < 0) a0 = 0;
                            const int r0 = (ns - nx * a0 + R - 1) / R, r1 = (ns - nx * (a0 + 1) + R - 1) / R;
                            const int c0 = (14 + 2 * a0 > 7 + 2 * r0) ? 14 + 2 * a0 : 7 + 2 * r0, c1 = (16 + 2 * a0 > 7 + 2 * r1) ? 16 + 2 * a0 : 7 + 2 * r1;
                            na = (c1 < c0 && ns - nx * (a0 + 1) >= 0) ? a0 + 1 : a0;
                            if (na * 256 > ns) { nx = 0; na = 0; }
                        }
                        unsigned char* Hd = ps == 0 ? F.ws + WS_A : (unsigned char*)F.out + HID1_OFF;
                        if (k >= 1) __syncthreads();
                        if (nM > 0) PHASE(16, {
                            pg8::MoeOrder S{nM, 2 * DFE / 256, F.G, F.bid, D / 2, p0, (const bf16*)(F.ws + WS_MGU), (size_t)2 * DFE * (D / 2), SEG, false, nx, na};
                            pg8::EpiSwigluF8 E{Hd, DFE, 1.f / (F8_SA * F8_SW), F8_SH};
                            pg8::gemm_phase<pg8::EpiSwigluF8, pg8::MoeOrder, D / 2, true, true, true, true>(F.lds, F.tid, Hb, (const int*)(F.ws + WS_MISC + MS_ST), (LAS int*)(F.lds + RTAB_OFF), S, E); });
                    }
                }
                SEAM(s0);
            }
            if (RUN(24)) PHASE(18, moe_combine_final_phase(F));
        }
    }
#undef PHASE
#undef RUN
#undef SEAM
}

extern "C" void kernel_launch(void* const* d_in, const int* in_sizes, int n_in, void* d_out, int out_size, void* d_ws, size_t ws_size, hipStream_t stream) {
    static int grid = 0;
    if (grid == 0) {
        if (n_in != 35 || out_size != T * D || ws_size < WS_END) { fprintf(stderr, "kernel_launch: unexpected sizes (n_in %d out %d ws %zu)\n", n_in, out_size, ws_size); grid = -1; return; }
        int dev = 0, cus = 0;
        if (hipGetDevice(&dev) != hipSuccess || hipDeviceGetAttribute(&cus, hipDeviceAttributeMultiprocessorCount, dev) != hipSuccess) { grid = -1; return; }
        if (hipFuncSetAttribute((const void*)mk_fwd, hipFuncAttributeMaxDynamicSharedMemorySize, LDS_BYTES) != hipSuccess) { grid = -1; return; }
        (void)hipGetLastError();
        grid = cus;
    }
    if (grid < 0) return;
    (void)hipMemsetAsync((char*)d_ws + WS_CTL, 0, CTL_ZERO_BYTES, stream);
    Params p{};
    for (int i = 0; i < 35; ++i) p.in[i] = (const float*)d_in[i];
    p.out = (float*)d_out; p.ws = (unsigned char*)d_ws;
#if MK_ONE_LAUNCH
    p.s_lo = 0; p.s_hi = NSTEPS;
    hipLaunchKernelGGL(mk_fwd, dim3(grid), dim3(NTHR), LDS_BYTES, stream, p);
#else
    for (int s = 0; s < NSTEPS; ++s) { p.s_lo = s; p.s_hi = s + 1; hipLaunchKernelGGL(mk_fwd, dim3(grid), dim3(NTHR), LDS_BYTES, stream, p); }
#endif
}
```
